# Optimizing an MI355X kernel written in HIP

```python
import jax, jax.numpy as jnp
from jax import lax
import numpy as np

D_MODEL = 2048
BATCH = 4
SEQ = 2048
DEPTH = 1
DEC_BATCH = 32
DEC_SEQ = 4
PAST_LEN = 8192
PAGE_SIZE = 128

HEAD_DIM = 128
HEADS_PER_GROUP = 4
DIL_GROUPS = ((128, 1), (512, 4), (2048, 16))
N_GROUPS = len(DIL_GROUPS)
N_HEADS = N_GROUPS * HEADS_PER_GROUP
ATT_WIDTH = N_HEADS * HEAD_DIM
ATT_OUT = HEADS_PER_GROUP * HEAD_DIM
SPAN = 128
ATT_SCALE = HEAD_DIM ** -0.5
ROT_DIM = HEAD_DIM // 4
ROPE_THETA = 500000.0
D_CONV = D_MODEL // 2
CONV_WIDTH = 31
FFN_HIDDEN = ((8 * D_MODEL + 3 * 256 - 1) // (3 * 256)) * 256
NORM_EPS = 1e-6
LN_EPS = 1e-5
IN_COLS = 2 * D_CONV + 3 * ATT_WIDTH + 2 * D_MODEL

kernel_name = "gated_conformer_dilated_swa_decoder_step"


def rms_norm(x, g):
    xf = x.astype(jnp.float32)
    y = xf * lax.rsqrt(jnp.mean(xf * xf, axis=-1, keepdims=True) + NORM_EPS)
    return (y * g.astype(jnp.float32)).astype(x.dtype)


def layer_norm(x, g, b):
    xf = x.astype(jnp.float32)
    mu = jnp.mean(xf, axis=-1, keepdims=True)
    xc = xf - mu
    var = jnp.mean(xc * xc, axis=-1, keepdims=True)
    y = xc * lax.rsqrt(var + LN_EPS) * g.astype(jnp.float32) + b.astype(jnp.float32)
    return y.astype(x.dtype)


def rope(x, pos):
    half = ROT_DIM // 2
    inv = jnp.power(ROPE_THETA, -jnp.arange(0, ROT_DIM, 2, dtype=jnp.float32) / ROT_DIM)
    ang = pos.astype(jnp.float32)[:, None] * inv[None, :]
    cos = jnp.cos(ang)[None, :, None, :]
    sin = jnp.sin(ang)[None, :, None, :]
    xf = x.astype(jnp.float32)
    x1 = xf[..., :half]
    x2 = xf[..., half:ROT_DIM]
    out = jnp.concatenate([x1 * cos - x2 * sin, x2 * cos + x1 * sin, xf[..., ROT_DIM:]], axis=-1)
    return out.astype(x.dtype)


def band_attention(q, k, v):
    N, L, H, hd = q.shape
    nb = -(-L // SPAN)
    Lp = nb * SPAN
    pad = ((0, 0), (0, Lp - L), (0, 0), (0, 0))
    qb = jnp.pad(q, pad).reshape(N, nb, SPAN, H, hd)
    kb = jnp.pad(k, pad).reshape(N, nb, SPAN, H, hd)
    vb = jnp.pad(v, pad).reshape(N, nb, SPAN, H, hd)

    def with_prev(t):
        prev = jnp.pad(t, ((0, 0), (1, 0), (0, 0), (0, 0), (0, 0)))[:, :-1]
        return jnp.concatenate([prev, t], axis=2)

    kk = with_prev(kb)
    vv = with_prev(vb)
    s = jnp.einsum('nbqhd,nbkhd->nbhqk', qb, kk,
                   preferred_element_type=jnp.float32) * ATT_SCALE
    qi = jnp.arange(SPAN)[:, None]
    ki = jnp.arange(2 * SPAN)[None, :]
    dist = SPAN + qi - ki
    blk = jnp.arange(nb)[:, None, None]
    valid = ((dist >= 0) & (dist <= SPAN))[None] & ((blk * SPAN - SPAN + ki[None]) >= 0)
    s = jnp.where(valid[None, :, None], s, -jnp.inf)
    m = jnp.max(s, axis=-1, keepdims=True)
    p = jnp.exp(s - m)
    den = jnp.sum(p, axis=-1)
    o = jnp.einsum('nbhqk,nbkhd->nbqhd', p, vv.astype(jnp.float32))
    o = o / jnp.transpose(den, (0, 1, 3, 2))[..., None]
    lse = jnp.transpose(m[..., 0] + jnp.log(den), (0, 1, 3, 2))
    o = o.reshape(N, Lp, H, hd)[:, :L].astype(q.dtype)
    lse = lse.reshape(N, Lp, H)[:, :L]
    return o, lse


def dilated_prompt(q, k, v, dil):
    B, S, H, hd = q.shape

    def to_streams(t):
        return t.reshape(B, S // dil, dil, H, hd).transpose(0, 2, 1, 3, 4).reshape(B * dil, S // dil, H, hd)

    o, lse = band_attention(to_streams(q), to_streams(k), to_streams(v))
    o = o.reshape(B, dil, S // dil, H, hd).transpose(0, 2, 1, 3, 4).reshape(B, S, H, hd)
    lse = lse.reshape(B, dil, S // dil, H).transpose(0, 2, 1, 3).reshape(B, S, H)
    return o, lse


def dilated_sample(q, k_new, v_new, k_buf, v_buf, dil):
    Wb = k_buf.shape[1]
    T = q.shape[1]
    kc = jnp.concatenate([k_buf, k_new], axis=1)
    vc = jnp.concatenate([v_buf, v_new], axis=1)
    i = jnp.arange(T)[:, None]
    j = jnp.arange(SPAN + 1)[None, :]
    idx = Wb + i - j * dil
    valid = idx >= 0
    idx = jnp.maximum(idx, 0)
    kg = kc[:, idx]
    vg = vc[:, idx]
    s = jnp.einsum('bthd,btjhd->bthj', q, kg,
                   preferred_element_type=jnp.float32) * ATT_SCALE
    s = jnp.where(valid[None, :, None, :], s, -jnp.inf)
    m = jnp.max(s, axis=-1, keepdims=True)
    p = jnp.exp(s - m)
    den = jnp.sum(p, axis=-1)
    o = jnp.einsum('bthj,btjhd->bthd', p, vg.astype(jnp.float32)) / den[..., None]
    lse = m[..., 0] + jnp.log(den)
    return o.astype(q.dtype), lse, kc[:, T:], vc[:, T:]


def combine_groups(outs, lses):
    w = jax.nn.softmax(jnp.stack(lses, axis=0), axis=0)
    o = jnp.einsum('gnlh,gnlhd->nlhd', w, jnp.stack(outs, axis=0).astype(jnp.float32))
    return o.astype(outs[0].dtype)


def head_group(t, g):
    return t[:, :, g * HEADS_PER_GROUP:(g + 1) * HEADS_PER_GROUP]


def prompt_attention(q, k, v):
    S = q.shape[1]
    outs, lses, new_k, new_v = [], [], [], []
    for g, (win, dil) in enumerate(DIL_GROUPS):
        kg, vg = head_group(k, g), head_group(v, g)
        o, lse = dilated_prompt(head_group(q, g), kg, vg, dil)
        outs.append(o)
        lses.append(lse)
        keep = min(win, S)
        new_k.append(kg[:, S - keep:])
        new_v.append(vg[:, S - keep:])
    return combine_groups(outs, lses), new_k, new_v


def sample_attention(q, k, v, k_bufs, v_bufs):
    outs, lses, new_k, new_v = [], [], [], []
    for g, (win, dil) in enumerate(DIL_GROUPS):
        o, lse, nk, nv = dilated_sample(head_group(q, g), head_group(k, g), head_group(v, g),
                                        k_bufs[g], v_bufs[g], dil)
        outs.append(o)
        lses.append(lse)
        new_k.append(nk)
        new_v.append(nv)
    return combine_groups(outs, lses), new_k, new_v


def conv_branch(u, u_past, w_dw, b_dw, ln_g, ln_b, w_pw, b_pw):
    uc = jnp.concatenate([u_past, u], axis=1)
    y = lax.conv_general_dilated(uc, w_dw[:, None, :], window_strides=(1,), padding='VALID',
                                 dimension_numbers=('NWC', 'WIO', 'NWC'),
                                 feature_group_count=D_CONV) + b_dw
    y = jax.nn.silu(layer_norm(y, ln_g, ln_b))
    return y @ w_pw + b_pw, uc[:, -(CONV_WIDTH - 1):]


def decoder_layer(x, pos, u_past, attend, g_mix, w_in, b_glu, w_dw, b_dw, ln_g, ln_b,
                  w_pw, b_pw, w_o_att, w_out, g_ffn, w_gate, w_up, w_down):
    N, L, _ = x.shape
    h = rms_norm(x, g_mix)
    z = h @ w_in
    o1 = 2 * D_CONV
    o2 = o1 + ATT_WIDTH
    o3 = o2 + ATT_WIDTH
    o4 = o3 + ATT_WIDTH
    o5 = o4 + D_MODEL
    glu = z[..., :o1] + b_glu
    u = glu[..., :D_CONV] * jax.nn.sigmoid(glu[..., D_CONV:])
    q = rope(z[..., o1:o2].reshape(N, L, N_HEADS, HEAD_DIM), pos)
    k = rope(z[..., o2:o3].reshape(N, L, N_HEADS, HEAD_DIM), pos)
    v = z[..., o3:o4].reshape(N, L, N_HEADS, HEAD_DIM)
    gate_conv = jax.nn.sigmoid(z[..., o4:o5])
    gate_attn = jax.nn.sigmoid(z[..., o5:])

    conv_out, new_conv = conv_branch(u, u_past, w_dw, b_dw, ln_g, ln_b, w_pw, b_pw)
    o_att, new_k, new_v = attend(q, k, v)
    attn_out = o_att.reshape(N, L, ATT_OUT) @ w_o_att

    x = x + (gate_conv * conv_out + gate_attn * attn_out) @ w_out
    hf = rms_norm(x, g_ffn)
    x = x + (jax.nn.silu(hf @ w_gate) * (hf @ w_up)) @ w_down
    return x, new_conv, new_k, new_v


def setup_inputs(seed: int = 0) -> dict:
    key = jax.random.key(seed)
    ks = iter(jax.random.split(key, 40))
    f32 = jnp.float32

    def nrm(shape, scale):
        return jax.random.normal(next(ks), shape, f32) * scale

    inp = {}
    inp['x_prompt'] = nrm((BATCH, SEQ, D_MODEL), 1.0)
    inp['x_sample'] = nrm((DEC_BATCH, DEC_SEQ, D_MODEL), 1.0)
    inp['state_conv'] = nrm((DEPTH, DEC_BATCH, CONV_WIDTH - 1, D_CONV), 1.0)
    for win, _ in DIL_GROUPS:
        wb = min(win, PAST_LEN)
        inp['cache_k_w%d' % win] = nrm((DEPTH, DEC_BATCH, wb, HEADS_PER_GROUP, HEAD_DIM), 1.0)
        inp['cache_v_w%d' % win] = nrm((DEPTH, DEC_BATCH, wb, HEADS_PER_GROUP, HEAD_DIM), 1.0)
    inp['g_mix'] = 1.0 + nrm((DEPTH, D_MODEL), 0.02)
    inp['w_in'] = nrm((DEPTH, D_MODEL, IN_COLS), D_MODEL ** -0.5)
    inp['b_glu'] = nrm((DEPTH, 2 * D_CONV), 0.02)
    inp['w_dw'] = nrm((DEPTH, CONV_WIDTH, D_CONV), CONV_WIDTH ** -0.5)
    inp['b_dw'] = nrm((DEPTH, D_CONV), 0.02)
    inp['ln_g'] = 1.0 + nrm((DEPTH, D_CONV), 0.02)
    inp['ln_b'] = nrm((DEPTH, D_CONV), 0.02)
    inp['w_pw'] = nrm((DEPTH, D_CONV, D_MODEL), D_CONV ** -0.5)
    inp['b_pw'] = nrm((DEPTH, D_MODEL), 0.02)
    inp['w_o_att'] = nrm((DEPTH, ATT_OUT, D_MODEL), ATT_OUT ** -0.5)
    inp['w_out'] = nrm((DEPTH, D_MODEL, D_MODEL), D_MODEL ** -0.5)
    inp['g_ffn'] = 1.0 + nrm((DEPTH, D_MODEL), 0.02)
    inp['w_gate'] = nrm((DEPTH, D_MODEL, FFN_HIDDEN), D_MODEL ** -0.5)
    inp['w_up'] = nrm((DEPTH, D_MODEL, FFN_HIDDEN), D_MODEL ** -0.5)
    inp['w_down'] = nrm((DEPTH, FFN_HIDDEN, D_MODEL), FFN_HIDDEN ** -0.5)
    inp['g_final'] = 1.0 + nrm((D_MODEL,), 0.02)
    return inp


def reference(x_prompt, x_sample, state_conv, cache_k_w128, cache_v_w128, cache_k_w512,
              cache_v_w512, cache_k_w2048, cache_v_w2048, g_mix, w_in, b_glu, w_dw, b_dw,
              ln_g, ln_b, w_pw, b_pw, w_o_att, w_out, g_ffn, w_gate, w_up, w_down, g_final):
    pos_p = jnp.arange(x_prompt.shape[1], dtype=jnp.int32)
    pos_s = PAST_LEN + jnp.arange(x_sample.shape[1], dtype=jnp.int32)
    xp, xs = x_prompt, x_sample
    conv_p, conv_s = [], []
    kp = [[] for _ in DIL_GROUPS]
    vp = [[] for _ in DIL_GROUPS]
    ks_ = [[] for _ in DIL_GROUPS]
    vs_ = [[] for _ in DIL_GROUPS]
    for l in range(DEPTH):
        lw = (g_mix[l], w_in[l], b_glu[l], w_dw[l], b_dw[l], ln_g[l], ln_b[l], w_pw[l], b_pw[l],
              w_o_att[l], w_out[l], g_ffn[l], w_gate[l], w_up[l], w_down[l])
        zero_past = jnp.zeros((xp.shape[0], CONV_WIDTH - 1, D_CONV), xp.dtype)
        xp, cp, nkp, nvp = decoder_layer(xp, pos_p, zero_past, prompt_attention, *lw)
        k_bufs = (cache_k_w128[l], cache_k_w512[l], cache_k_w2048[l])
        v_bufs = (cache_v_w128[l], cache_v_w512[l], cache_v_w2048[l])
        attend_s = lambda q, k, v, kb=k_bufs, vb=v_bufs: sample_attention(q, k, v, kb, vb)
        xs, cs, nks, nvs = decoder_layer(xs, pos_s, state_conv[l], attend_s, *lw)
        conv_p.append(cp)
        conv_s.append(cs)
        for g in range(N_GROUPS):
            kp[g].append(nkp[g])
            vp[g].append(nvp[g])
            ks_[g].append(nks[g])
            vs_[g].append(nvs[g])
    y_prompt = rms_norm(xp, g_final)
    y_sample = rms_norm(xs, g_final)
    st = lambda lst: jnp.stack(lst, axis=0)
    return (y_prompt, y_sample, st(conv_p), st(conv_s),
            st(kp[0]), st(ks_[0]), st(vp[0]), st(vs_[0]),
            st(kp[1]), st(ks_[1]), st(vp[1]), st(vs_[1]),
            st(kp[2]), st(ks_[2]), st(vp[2]), st(vs_[2]))
```

```cpp
#include <hip/hip_runtime.h>
#include <hip/hip_cooperative_groups.h>
#include <cstdio>
#include <cstdint>
namespace cg = cooperative_groups;

#ifndef MK_SPLIT
#define MK_SPLIT 0
#endif

#define LAS __attribute__((address_space(3)))
typedef unsigned short bf16_t;
typedef short bf16x8 __attribute__((ext_vector_type(8)));
typedef short s16x4 __attribute__((ext_vector_type(4)));
typedef float f32x4 __attribute__((ext_vector_type(4)));
typedef float f32x2 __attribute__((ext_vector_type(2)));
typedef unsigned u32x4 __attribute__((ext_vector_type(4)));
typedef unsigned u32x2 __attribute__((ext_vector_type(2)));

constexpr int DM = 2048, NPR = 8192, MR = 8320, MP = 8448;
constexpr int DC = 1024, AW = 1536, AO = 512, FH = 5632, INC = 10752;
constexpr float NORM_EPS = 1e-6f, LN_EPS = 1e-5f;
constexpr float ATT_SCALE_LOG2E = 0.08838834764831845f * 1.4426950408889634f;
constexpr float LN2F = 0.6931471805599453f;

constexpr size_t OFF_YP = 0, OFF_YS = (size_t)NPR * DM, OFF_CONVP = (size_t)MR * DM, OFF_CONVS = OFF_CONVP + 4 * 30 * 1024, OFF_KV = OFF_CONVS + 32 * 30 * 1024;
__host__ __device__ constexpr size_t kv_group_base(int g) { return OFF_KV + (g == 0 ? 0 : (g == 1 ? (size_t)2 * 36 * 128 * 512 : (size_t)2 * 36 * (128 + 512) * 512)); }

constexpr size_t MiB = 1u << 20;
constexpr size_t WS_CTL = 0;
constexpr size_t WS_SS1 = 1 * MiB, WS_SS2 = WS_SS1 + 64 * 1024;
constexpr size_t WS_ROPE = 2 * MiB;
constexpr size_t WS_LSE = 3 * MiB;
constexpr size_t WS_WIN = 4 * MiB;
constexpr size_t WS_WPW = WS_WIN + (size_t)INC * DM * 2;
constexpr size_t WS_WOA = WS_WPW + (size_t)DM * DC * 2;
constexpr size_t WS_WOUT = WS_WOA + (size_t)DM * AO * 2;
constexpr size_t WS_WGU = WS_WOUT + (size_t)DM * DM * 2;
constexpr size_t WS_WDN = WS_WGU + (size_t)2 * FH * DM * 2;
constexpr size_t WS_XA = WS_WDN + (size_t)DM * FH * 2;
constexpr size_t WS_T1 = WS_XA + (size_t)MP * DM * 2;
constexpr size_t WS_MIX = WS_T1 + (size_t)MP * DM * 4;
constexpr size_t WS_X1 = WS_MIX + (size_t)MP * DM * 2;
constexpr size_t WS_C = WS_X1 + (size_t)MP * DM * 4;
constexpr size_t WS_U = WS_C;
constexpr size_t WS_Q = WS_U + (size_t)MP * DC * 2;
constexpr size_t WS_K = WS_Q + (size_t)MP * AW * 2;
constexpr size_t WS_V = WS_K + (size_t)MP * AW * 2;
constexpr size_t WS_GC = WS_V + (size_t)MP * AW * 2;
constexpr size_t WS_GA = WS_GC + (size_t)MP * DM * 2;
constexpr size_t WS_CACT = WS_GA + (size_t)MP * DM * 2;
constexpr size_t WS_OG = WS_CACT + (size_t)MP * DC * 2;
constexpr size_t WS_OATT = WS_OG + (size_t)3 * MP * AO * 2;
constexpr size_t WS_CEND = WS_OATT + (size_t)MP * AO * 2;
constexpr size_t WS_HID = WS_C;
static_assert(WS_HID + (size_t)MP * FH * 2 <= WS_CEND, "HID overlay fits region C");
constexpr size_t WS_END = WS_CEND;

constexpr int LDS_BYTES = 147456;

struct Args { const float* in[25]; float* out; unsigned char* ws; int ph_lo, ph_hi; };

__device__ __forceinline__ unsigned cvt_pk_bf16(float lo, float hi) { unsigned r; asm("v_cvt_pk_bf16_f32 %0, %1, %2" : "=v"(r) : "v"(lo), "v"(hi)); return r; }
__device__ __forceinline__ float bf_lo(unsigned w) { return __uint_as_float(w << 16); }
__device__ __forceinline__ float bf_hi(unsigned w) { return __uint_as_float(w & 0xffff0000u); }
__device__ __forceinline__ float sigmoidf_(float x) { return __builtin_amdgcn_rcpf(1.0f + __expf(-x)); }
__device__ __forceinline__ u32x4 pack8(const f32x4& a, const f32x4& b) { u32x4 w; w.x = cvt_pk_bf16(a[0], a[1]); w.y = cvt_pk_bf16(a[2], a[3]); w.z = cvt_pk_bf16(b[0], b[1]); w.w = cvt_pk_bf16(b[2], b[3]); return w; }
__device__ __forceinline__ void unpack8(const u32x4& w, f32x4& a, f32x4& b) { a[0] = bf_lo(w.x); a[1] = bf_hi(w.x); a[2] = bf_lo(w.y); a[3] = bf_hi(w.y); b[0] = bf_lo(w.z); b[1] = bf_hi(w.z); b[2] = bf_lo(w.w); b[3] = bf_hi(w.w); }
__host__ __device__ __forceinline__ int perm32(int rho) { const int n = rho >> 4, i = rho & 15; return 8 * (i >> 2) + 4 * n + (i & 3); }

constexpr int CS_NCHUNK = 42816, CS_LDS_OFF = 131072;
struct CacheStream {
    int ci, c, step;
    const float* out;
    const float* sbase; float* dbase; int ncache;
    const float* cur_src; float* cur_dst;
    bool inflight, ready;
    __device__ __forceinline__ void setup(LAS unsigned char* lds) {
        while (ci < 6) { const int cpb = (32 << (2 * (ci >> 1))) - 1; ncache = 32 * cpb; if (c < ncache) break; c -= ncache; ++ci; }
        if (ci < 6) {
            const int g = ci >> 1, Wb = 128 << (2 * g);
            const unsigned long long sp = ((const LAS unsigned long long*)(lds + LDS_BYTES - 128))[ci];
            const unsigned lo = __builtin_amdgcn_readfirstlane((unsigned)sp), hi = __builtin_amdgcn_readfirstlane((unsigned)(sp >> 32));
            sbase = (const float*)(((unsigned long long)hi << 32) | lo);
            dbase = const_cast<float*>(out) + kv_group_base(g) + ((ci & 1) ? (size_t)40 * Wb * 512 : (size_t)4 * Wb * 512);
        }
    }
    __device__ __forceinline__ void decode_next(LAS unsigned char* lds) {
        const int g = ci >> 1, bb = g == 0 ? c / 31 : (g == 1 ? c / 127 : c / 511);
        cur_src = sbase + (size_t)(c + bb + 1) * 2048; cur_dst = dbase + (size_t)(c + bb) * 2048;
        c += step; if (c >= ncache) { c -= ncache; ++ci; setup(lds); }
    }
    __device__ __forceinline__ void load(LAS unsigned char* lds, int tid, unsigned ldsw) {
        if (ready) { __builtin_amdgcn_global_load_lds((const unsigned*)(cur_src + tid * 4), (LAS unsigned*)(lds + CS_LDS_OFF + ldsw), 16, 0, 0); ready = false; inflight = true; }
    }
    __device__ __forceinline__ void store(LAS unsigned char* lds, int tid) {
        if (inflight) { const f32x4 v = *(const LAS f32x4*)(lds + CS_LDS_OFF + tid * 16); *(f32x4*)(cur_dst + tid * 4) = v; inflight = false; }
        if (!ready && ci < 6) { decode_next(lds); ready = true; }
    }
};
struct NoStream {
    __device__ __forceinline__ void load(LAS unsigned char*, int, unsigned) {}
    __device__ __forceinline__ void store(LAS unsigned char*, int) {}
};

namespace pg8 {
constexpr int BM = 256, BK = 64, HALF = 128, HTB = HALF * BK * 2, STAGE_BYTES = 8 * HTB, NXCD = 8, WGM = 8;
__host__ __device__ __forceinline__ int lds_byte(int r, int c) { const int st = (r >> 4) * 2 + (c >> 5), rr = r & 15, cc = c & 31, ob = rr * 64 + cc * 2; return st * 1024 + (ob ^ (((ob >> 9) & 1) << 5)); }
__host__ __device__ __forceinline__ void stage_rc(int b, int& R, int& C) { const int st = b / 1024, sb = b % 1024, swz = sb ^ (((sb >> 9) & 1) << 5); R = (st >> 1) * 16 + swz / 64; C = (st & 1) * 32 + (swz % 64) / 2; }
struct Unit { int pm, pn; };
struct Gemm { const bf16_t* A; const bf16_t* Bt; int M, N, K; };
struct StaticOrder {
    int nM, nN, nwg, G, c;
    __host__ __device__ void init(int M, int N, int G_, int c_) { nM = M / BM; nN = N / BM; nwg = nM * nN; G = G_; c = c_; }
    __host__ __device__ bool next(int i, Unit& u) const {
        const long L = (long)i * G + c; if (L >= nwg) return false;
        int wgid = (int)L; { const int q = nwg / NXCD, r = nwg % NXCD, xcd = wgid % NXCD, off = wgid / NXCD; wgid = (xcd < r ? xcd * (q + 1) : r * (q + 1) + (xcd - r) * q) + off; }
        const int nig = WGM * nN, gid = wgid / nig, fm = gid * WGM, gsz = (nM - fm) < WGM ? (nM - fm) : WGM;
        u.pm = fm + ((wgid % nig) % gsz); u.pn = (wgid % nig) / gsz; return true;
    }
};
template <class Epi, class Cp>
__device__ __forceinline__ void gemm_phase(LAS unsigned char* lds, const Gemm g, const StaticOrder& S, const Epi& E, Cp& cp) {
    const int tid = threadIdx.x, wid = __builtin_amdgcn_readfirstlane(tid >> 6), lane = tid & 63, wr = wid >> 2, wc = wid & 3, fr = lane & 15, fq = lane >> 4;
    const int K = g.K, nt = K / BK;
    unsigned voffA[2];
#pragma unroll
    for (int i = 0; i < 2; ++i) { int R, C; stage_rc(tid * 16 + i * 8192, R, C); voffA[i] = (unsigned)(R * K + C) * 2u; }
    const size_t kstep = (size_t)(BK * 2);
    const size_t hstep = (size_t)HALF * K * 2;
    const size_t tstep = 2 * hstep;
    const unsigned ldsw = (unsigned)wid * 1024u;
    const int aoff = lds_byte(wr * 64 + fr, fq * 8), boff = lds_byte(wc * 32 + fr, fq * 8);
#define PG8_SA(b, h) (((b) * 2 + (h)) * HTB)
#define PG8_SB(b, h) ((4 + (b) * 2 + (h)) * HTB)
#define PG8_STAGE(bufoff, gbase, voff) do { _Pragma("unroll") for (int _i = 0; _i < 2; ++_i) \
        __builtin_amdgcn_global_load_lds((const unsigned*)((const char*)(gbase) + (voff)[_i]), (LAS unsigned*)(lds + (bufoff) + ldsw + _i * 8192), 16, 0, 0); } while (0)
#define PG8_LDA(dst, b, h) do { _Pragma("unroll") for (int m = 0; m < 4; ++m) _Pragma("unroll") for (int k = 0; k < 2; ++k) dst[m][k] = *(const LAS bf16x8*)(lds + PG8_SA(b, h) + aoff + m * 2048 + k * 1024); } while (0)
#define PG8_LDB(dst, b, h) do { _Pragma("unroll") for (int n = 0; n < 2; ++n) _Pragma("unroll") for (int k = 0; k < 2; ++k) dst[n][k] = *(const LAS bf16x8*)(lds + PG8_SB(b, h) + boff + n * 2048 + k * 1024); } while (0)
#define PG8_MMA(ai, bj, At, Bt) do { __builtin_amdgcn_s_setprio(1); _Pragma("unroll") for (int m = 0; m < 4; ++m) _Pragma("unroll") for (int n = 0; n < 2; ++n) _Pragma("unroll") for (int k = 0; k < 2; ++k) \
        acc[ai][bj][m][n] = __builtin_amdgcn_mfma_f32_16x16x32_bf16(Bt[n][k], At[m][k], acc[ai][bj][m][n], 0, 0, 0); __builtin_amdgcn_s_setprio(0); } while (0)
#define PG8_WAIT_V(n) asm volatile("s_waitcnt vmcnt(" #n ")" ::: "memory")
#define PG8_WAIT_L(n) asm volatile("s_waitcnt lgkmcnt(" #n ")" ::: "memory")
#define PG8_BAR __builtin_amdgcn_s_barrier()
#define PG8_SCHED __builtin_amdgcn_sched_barrier(0)
    Unit cur, nxt; int ui = 0;
    if (!S.next(0, cur)) return;
    f32x4 acc[2][2][4][2];
#pragma unroll
    for (int a = 0; a < 2; ++a)
#pragma unroll
        for (int b = 0; b < 2; ++b)
#pragma unroll
            for (int m = 0; m < 4; ++m)
#pragma unroll
                for (int n = 0; n < 2; ++n) acc[a][b][m][n] = (f32x4){0.f, 0.f, 0.f, 0.f};
    bf16x8 At[4][2], B0[2][2], B1[2][2];
    const char* cA = (const char*)g.A + (size_t)cur.pm * tstep; const char* cB = (const char*)g.Bt + (size_t)cur.pn * tstep;
    PG8_STAGE(PG8_SB(0, 0), cB, voffA); PG8_STAGE(PG8_SA(0, 0), cA, voffA); PG8_STAGE(PG8_SB(0, 1), cB + hstep, voffA); PG8_STAGE(PG8_SA(0, 1), cA + hstep, voffA);
    if (wr == 1) PG8_BAR;
    PG8_WAIT_V(4); PG8_BAR;
    PG8_STAGE(PG8_SB(1, 0), cB + kstep, voffA); PG8_STAGE(PG8_SA(1, 0), cA + kstep, voffA); PG8_STAGE(PG8_SB(1, 1), cB + hstep + kstep, voffA);
    PG8_WAIT_V(6); PG8_BAR;
    for (;;) {
        const bool has_next = S.next(ui + 1, nxt);
        const char* nA = has_next ? (const char*)g.A + (size_t)nxt.pm * tstep : cA; const char* nB = has_next ? (const char*)g.Bt + (size_t)nxt.pn * tstep : cB;
        for (int t = 0; t < nt; t += 2) {
            const bool last = (t == nt - 2);
            const char* a1 = cA + (size_t)(t + 1) * kstep;
            const char* a2 = last ? nA : cA + (size_t)(t + 2) * kstep; const char* b2 = last ? nB : cB + (size_t)(t + 2) * kstep;
            const char* a3 = a2 + kstep; const char* b3 = b2 + kstep;
            PG8_LDB(B0, 0, 0); PG8_SCHED; PG8_LDA(At, 0, 0); PG8_STAGE(PG8_SA(1, 1), a1 + hstep, voffA);
            PG8_WAIT_L(8); PG8_BAR; PG8_WAIT_L(0); PG8_MMA(0, 0, At, B0); PG8_BAR; PG8_SCHED;
            PG8_LDB(B1, 0, 1); PG8_STAGE(PG8_SB(0, 0), b2, voffA);
            PG8_BAR; PG8_WAIT_L(0); PG8_MMA(0, 1, At, B1); PG8_BAR;
            PG8_LDA(At, 0, 1); PG8_STAGE(PG8_SA(0, 0), a2, voffA);
            PG8_BAR; PG8_WAIT_L(0); PG8_MMA(1, 0, At, B0); PG8_BAR; PG8_SCHED;
            PG8_STAGE(PG8_SB(0, 1), b2 + hstep, voffA);
            PG8_WAIT_V(6); cp.load(lds, tid, ldsw); PG8_BAR; PG8_MMA(1, 1, At, B1); PG8_BAR;
            PG8_LDB(B0, 1, 0); PG8_SCHED; PG8_LDA(At, 1, 0); PG8_STAGE(PG8_SA(0, 1), a2 + hstep, voffA);
            PG8_WAIT_L(8); PG8_BAR; PG8_WAIT_L(0); PG8_MMA(0, 0, At, B0); PG8_BAR; PG8_SCHED;
            PG8_LDB(B1, 1, 1); PG8_STAGE(PG8_SB(1, 0), b3, voffA);
            PG8_BAR; PG8_WAIT_L(0); PG8_MMA(0, 1, At, B1); PG8_BAR;
            PG8_LDA(At, 1, 1); PG8_STAGE(PG8_SA(1, 0), a3, voffA);
            PG8_BAR; PG8_WAIT_L(0); PG8_MMA(1, 0, At, B0); PG8_BAR; PG8_SCHED;
            PG8_STAGE(PG8_SB(1, 1), b3 + hstep, voffA);
            PG8_WAIT_V(6); PG8_BAR; PG8_MMA(1, 1, At, B1); cp.store(lds, tid); PG8_BAR;
        }
        E(acc, cur, wr, wc, fr, fq);
        if (!has_next) break;
#pragma unroll
        for (int a = 0; a < 2; ++a)
#pragma unroll
            for (int b = 0; b < 2; ++b)
#pragma unroll
                for (int m = 0; m < 4; ++m)
#pragma unroll
                    for (int n = 0; n < 2; ++n) acc[a][b][m][n] = (f32x4){0.f, 0.f, 0.f, 0.f};
        cur = nxt; cA = nA; cB = nB; ++ui;
    }
    PG8_WAIT_V(0);
    if (wr == 0) PG8_BAR;
    PG8_BAR;
#undef PG8_SA
#undef PG8_SB
#undef PG8_STAGE
#undef PG8_LDA
#undef PG8_LDB
#undef PG8_MMA
#undef PG8_WAIT_V
#undef PG8_WAIT_L
#undef PG8_BAR
#undef PG8_SCHED
}
}
using pg8::Unit;

struct RowInfo { int b, t, pidx; bool prompt; };
__device__ __forceinline__ RowInfo row_info(int row) { RowInfo r; r.prompt = row < NPR; if (r.prompt) { r.b = row >> 11; r.t = row & 2047; r.pidx = r.t; } else { const int s = row - NPR; r.b = s >> 2; r.t = s & 3; r.pidx = 2048 + r.t; } return r; }

struct EpiIn {
    bf16_t *U, *Q, *K, *V, *GC, *GA; float* out; const float* bglu; const float* rope;
    __device__ __forceinline__ void kv_out(bool isK, const RowInfo& ri, int head, int dim, const f32x4& v0, const f32x4& v1, bool split16) const {
        const int g = head >> 2, hs = head & 3, win = 128 << (2 * g);
        const size_t gb = kv_group_base(g);
        size_t off;
        if (ri.prompt) { if (ri.t < 2048 - win) return; off = gb + (isK ? 0 : (size_t)36 * win * 512) + ((size_t)(ri.b * win + (ri.t - (2048 - win))) * 4 + hs) * 128 + dim; }
        else off = gb + (isK ? (size_t)4 * win * 512 : (size_t)40 * win * 512) + ((size_t)(ri.b * win + win - 4 + ri.t) * 4 + hs) * 128 + dim;
        *(f32x4*)(out + off) = v0; *(f32x4*)(out + off + (split16 ? 16 : 4)) = v1;
    }
    __device__ __forceinline__ void row(int row, int pn, int wc, int fq, const f32x4 (&v)[2][2]) const {
        if (row >= MR) return;
        const RowInfo ri = row_info(row);
        if (pn < 8) {
            const int c0 = pn * 128 + wc * 32 + fq * 8;
            f32x4 uu[2];
#pragma unroll
            for (int n = 0; n < 2; ++n) {
                const f32x4 ba = *(const f32x4*)(bglu + c0 + 4 * n), bb = *(const f32x4*)(bglu + 1024 + c0 + 4 * n);
#pragma unroll
                for (int j = 0; j < 4; ++j) uu[n][j] = (v[0][n][j] + ba[j]) * sigmoidf_(v[1][n][j] + bb[j]);
            }
            *(u32x4*)(U + (size_t)row * DC + c0) = pack8(uu[0], uu[1]);
            if (ri.prompt) { if (ri.t >= 2018) { float* o = out + OFF_CONVP + ((size_t)(ri.b * 30 + ri.t - 2018)) * 1024 + c0; *(f32x4*)o = uu[0]; *(f32x4*)(o + 4) = uu[1]; } }
            else { float* o = out + OFF_CONVS + ((size_t)(ri.b * 30 + 26 + ri.t)) * 1024 + c0; *(f32x4*)o = uu[0]; *(f32x4*)(o + 4) = uu[1]; }
        } else if (pn < 20) {
            const bool isK = pn >= 14; bf16_t* buf = isK ? K : Q; const int hp = (isK ? pn - 14 : pn - 8) * 2;
#pragma unroll
            for (int bj = 0; bj < 2; ++bj) {
                const int head = hp + bj; bf16_t* dst = buf + (size_t)row * AW + head * 128;
                if (wc == 0) {
                    const f32x4 x1 = v[bj][0], x2 = v[bj][1];
                    const float* rp = rope + ((size_t)ri.pidx * 16 + 4 * fq) * 2;
                    const f32x4 cs0 = *(const f32x4*)rp, cs1 = *(const f32x4*)(rp + 4);
                    f32x4 o1, o2;
                    o1[0] = x1[0] * cs0[0] - x2[0] * cs0[1]; o2[0] = x2[0] * cs0[0] + x1[0] * cs0[1];
                    o1[1] = x1[1] * cs0[2] - x2[1] * cs0[3]; o2[1] = x2[1] * cs0[2] + x1[1] * cs0[3];
                    o1[2] = x1[2] * cs1[0] - x2[2] * cs1[1]; o2[2] = x2[2] * cs1[0] + x1[2] * cs1[1];
                    o1[3] = x1[3] * cs1[2] - x2[3] * cs1[3]; o2[3] = x2[3] * cs1[2] + x1[3] * cs1[3];
                    u32x2 w1, w2; w1.x = cvt_pk_bf16(o1[0], o1[1]); w1.y = cvt_pk_bf16(o1[2], o1[3]); w2.x = cvt_pk_bf16(o2[0], o2[1]); w2.y = cvt_pk_bf16(o2[2], o2[3]);
                    *(u32x2*)(dst + 4 * fq) = w1; *(u32x2*)(dst + 16 + 4 * fq) = w2;
                    if (isK) kv_out(true, ri, head, 4 * fq, o1, o2, true);
                } else {
                    const int d0 = wc * 32 + fq * 8;
                    *(u32x4*)(dst + d0) = pack8(v[bj][0], v[bj][1]);
                    if (isK) kv_out(true, ri, head, d0, v[bj][0], v[bj][1], false);
                }
            }
        } else if (pn < 26) {
            const int hp = (pn - 20) * 2, d0 = wc * 32 + fq * 8;
#pragma unroll
            for (int bj = 0; bj < 2; ++bj) {
                const int head = hp + bj;
                *(u32x4*)(V + (size_t)row * AW + head * 128 + d0) = pack8(v[bj][0], v[bj][1]);
                kv_out(false, ri, head, d0, v[bj][0], v[bj][1], false);
            }
        } else {
            bf16_t* buf = pn < 34 ? GC : GA; const int cb = (pn < 34 ? pn - 26 : pn - 34) * 256 + wc * 32 + fq * 8;
#pragma unroll
            for (int bj = 0; bj < 2; ++bj) {
                f32x4 g0, g1;
#pragma unroll
                for (int j = 0; j < 4; ++j) { g0[j] = sigmoidf_(v[bj][0][j]); g1[j] = sigmoidf_(v[bj][1][j]); }
                *(u32x4*)(buf + (size_t)row * DM + cb + bj * 128) = pack8(g0, g1);
            }
        }
    }
};
struct EpiPw {
    bf16_t* T1; const bf16_t* GC; const float* bpw;
    __device__ __forceinline__ void row(int row, int pn, int wc, int fq, const f32x4 (&v)[2][2]) const {
        if (row >= MR) return;
#pragma unroll
        for (int bj = 0; bj < 2; ++bj) {
            const int c0 = pn * 256 + bj * 128 + wc * 32 + fq * 8;
            const f32x4 b0 = *(const f32x4*)(bpw + c0), b1 = *(const f32x4*)(bpw + c0 + 4);
            f32x4 g0, g1; unpack8(*(const u32x4*)(GC + (size_t)row * DM + c0), g0, g1);
            *(u32x4*)(T1 + (size_t)row * DM + c0) = pack8((v[bj][0] + b0) * g0, (v[bj][1] + b1) * g1);
        }
    }
};
struct EpiOa {
    const bf16_t* T1; const bf16_t* GA; bf16_t* MIX;
    __device__ __forceinline__ void row(int row, int pn, int wc, int fq, const f32x4 (&v)[2][2]) const {
        if (row >= MR) return;
#pragma unroll
        for (int bj = 0; bj < 2; ++bj) {
            const int c0 = pn * 256 + bj * 128 + wc * 32 + fq * 8;
            f32x4 g0, g1; unpack8(*(const u32x4*)(GA + (size_t)row * DM + c0), g0, g1);
            f32x4 t0, t1; unpack8(*(const u32x4*)(T1 + (size_t)row * DM + c0), t0, t1);
            *(u32x4*)(MIX + (size_t)row * DM + c0) = pack8(t0 + v[bj][0] * g0, t1 + v[bj][1] * g1);
        }
    }
};
struct EpiRes {
    const float* xp; const float* xs; size_t xs_row0;
    float* XO; bf16_t* XB; float* SS; const bf16_t* SB;
    __device__ __forceinline__ void row(int row, int pn, int wc, int fq, const f32x4 (&v)[2][2]) const {
        const bool ok = row < MR;
        float ss = 0.f;
        if (ok) {
            const float* src = row < NPR ? xp + (size_t)row * DM : xs + ((size_t)row - xs_row0) * DM;
#pragma unroll
            for (int bj = 0; bj < 2; ++bj) {
                const int c0 = pn * 256 + bj * 128 + wc * 32 + fq * 8;
                f32x4 r0, r1;
                if (SB) unpack8(*(const u32x4*)(SB + (size_t)row * DM + c0), r0, r1); else { r0 = *(const f32x4*)(src + c0); r1 = *(const f32x4*)(src + c0 + 4); }
                const f32x4 v0 = r0 + v[bj][0], v1 = r1 + v[bj][1];
                if (XO) { float* o = XO + (size_t)row * DM + c0; *(f32x4*)o = v0; *(f32x4*)(o + 4) = v1; }
                if (XB) *(u32x4*)(XB + (size_t)row * DM + c0) = pack8(v0, v1);
                ss += v0[0] * v0[0] + v0[1] * v0[1] + v0[2] * v0[2] + v0[3] * v0[3] + v1[0] * v1[0] + v1[1] * v1[1] + v1[2] * v1[2] + v1[3] * v1[3];
            }
        }
        ss += __shfl_xor(ss, 16); ss += __shfl_xor(ss, 32);
        if (ok && fq == 0) atomicAdd(SS + row, ss);
    }
};
struct EpiGu {
    const float* SS; bf16_t* HID;
    __device__ __forceinline__ void row(int row, int pn, int wc, int fq, const f32x4 (&v)[2][2]) const {
        if (row >= MR) return;
        const int c0 = pn * 128 + wc * 32 + fq * 8;
        const float r = __builtin_amdgcn_rsqf(SS[row] * (1.0f / DM) + NORM_EPS);
        f32x4 h[2];
#pragma unroll
        for (int n = 0; n < 2; ++n)
#pragma unroll
            for (int j = 0; j < 4; ++j) { const float gt = v[0][n][j] * r, up = v[1][n][j] * r; h[n][j] = gt * sigmoidf_(gt) * up; }
        *(u32x4*)(HID + (size_t)row * FH + c0) = pack8(h[0], h[1]);
    }
};
constexpr int CW_FIN = 4096;
struct EpiFinalTile {
    const bf16_t* XB; float* out; float* SS; unsigned* cnt; const float* gfin;
    __device__ __forceinline__ void operator()(const f32x4 (&acc)[2][2][4][2], const Unit& u, int wr, int wc, int fr, int fq) const {
        const int rowb = u.pm * 256 + wr * 64 + fr;
#pragma unroll
        for (int ai = 0; ai < 2; ++ai)
#pragma unroll
            for (int m = 0; m < 4; ++m) {
                const int row = rowb + ai * 128 + m * 16; float ss = 0.f;
#pragma unroll
                for (int bj = 0; bj < 2; ++bj) {
                    const int c0 = u.pn * 256 + bj * 128 + wc * 32 + fq * 8;
                    f32x4 r0, r1; unpack8(*(const u32x4*)(XB + (size_t)row * DM + c0), r0, r1);
                    const f32x4 v0 = r0 + acc[ai][bj][m][0], v1 = r1 + acc[ai][bj][m][1];
                    ss += v0[0] * v0[0] + v0[1] * v0[1] + v0[2] * v0[2] + v0[3] * v0[3] + v1[0] * v1[0] + v1[1] * v1[1] + v1[2] * v1[2] + v1[3] * v1[3];
                }
                ss += __shfl_xor(ss, 16); ss += __shfl_xor(ss, 32);
                if (fq == 0) atomicAdd(SS + row, ss);
            }
        asm volatile("s_waitcnt vmcnt(0)" ::: "memory");
        unsigned* c = cnt + CW_FIN + 64 * (2 * u.pm + wr);
        if ((threadIdx.x & 63) == 0) {
            (void)__hip_atomic_fetch_add(c, 1u, __ATOMIC_RELAXED, __HIP_MEMORY_SCOPE_AGENT);
            unsigned sp = 0;
            while (__hip_atomic_load(c, __ATOMIC_RELAXED, __HIP_MEMORY_SCOPE_AGENT) < 32u) { __builtin_amdgcn_s_sleep(1); if (++sp > (1u << 17)) break; }
        }
        asm volatile("" ::: "memory");
#pragma unroll
        for (int ai = 0; ai < 2; ++ai)
#pragma unroll
            for (int m = 0; m < 4; ++m) {
                const int row = rowb + ai * 128 + m * 16;
                const float r = __builtin_amdgcn_rsqf(__hip_atomic_load(SS + row, __ATOMIC_RELAXED, __HIP_MEMORY_SCOPE_AGENT) * (1.0f / DM) + NORM_EPS);
#pragma unroll
                for (int bj = 0; bj < 2; ++bj) {
                    const int c0 = u.pn * 256 + bj * 128 + wc * 32 + fq * 8;
                    f32x4 r0, r1; unpack8(*(const u32x4*)(XB + (size_t)row * DM + c0), r0, r1);
                    const f32x4 g0 = *(const f32x4*)(gfin + c0), g1 = *(const f32x4*)(gfin + c0 + 4);
                    float* o = out + (size_t)row * DM + c0;
                    *(f32x4*)o = (r0 + acc[ai][bj][m][0]) * r * g0; *(f32x4*)(o + 4) = (r1 + acc[ai][bj][m][1]) * r * g1;
                }
            }
    }
};

struct EpiFinalRow {
    const bf16_t* XB; float* out; float* SS; unsigned* cnt; const float* gfin;
    __device__ __forceinline__ void row(int row, int pn, int wc, int fq, const f32x4 (&v)[2][2]) const {
        f32x4 x0[2], x1[2]; float ss = 0.f;
#pragma unroll
        for (int bj = 0; bj < 2; ++bj) {
            const int c0 = pn * 256 + bj * 128 + wc * 32 + fq * 8;
            f32x4 r0, r1; unpack8(*(const u32x4*)(XB + (size_t)row * DM + c0), r0, r1);
            x0[bj] = r0 + v[bj][0]; x1[bj] = r1 + v[bj][1];
            ss += x0[bj][0] * x0[bj][0] + x0[bj][1] * x0[bj][1] + x0[bj][2] * x0[bj][2] + x0[bj][3] * x0[bj][3] + x1[bj][0] * x1[bj][0] + x1[bj][1] * x1[bj][1] + x1[bj][2] * x1[bj][2] + x1[bj][3] * x1[bj][3];
        }
        ss += __shfl_xor(ss, 16); ss += __shfl_xor(ss, 32);
        if (fq == 0) atomicAdd(SS + row, ss);
        asm volatile("s_waitcnt vmcnt(0)" ::: "memory");
        unsigned* c = cnt + CW_FIN + 64 * (64 + ((row - NPR) >> 4));
        if ((threadIdx.x & 63) == 0) {
            (void)__hip_atomic_fetch_add(c, 1u, __ATOMIC_RELAXED, __HIP_MEMORY_SCOPE_AGENT);
            unsigned sp = 0;
            while (__hip_atomic_load(c, __ATOMIC_RELAXED, __HIP_MEMORY_SCOPE_AGENT) < 32u) { __builtin_amdgcn_s_sleep(1); if (++sp > (1u << 17)) break; }
        }
        asm volatile("" ::: "memory");
        const float r = __builtin_amdgcn_rsqf(__hip_atomic_load(SS + row, __ATOMIC_RELAXED, __HIP_MEMORY_SCOPE_AGENT) * (1.0f / DM) + NORM_EPS);
#pragma unroll
        for (int bj = 0; bj < 2; ++bj) {
            const int c0 = pn * 256 + bj * 128 + wc * 32 + fq * 8;
            const f32x4 g0 = *(const f32x4*)(gfin + c0), g1 = *(const f32x4*)(gfin + c0 + 4);
            float* o = out + (size_t)row * DM + c0;
            *(f32x4*)o = x0[bj] * r * g0; *(f32x4*)(o + 4) = x1[bj] * r * g1;
        }
    }
};

template <class Epi> struct TileEpi {
    Epi e;
    __device__ __forceinline__ void operator()(const f32x4 (&acc)[2][2][4][2], const Unit& u, int wr, int wc, int fr, int fq) const {
#pragma unroll
        for (int ai = 0; ai < 2; ++ai)
#pragma unroll
            for (int m = 0; m < 4; ++m) {
                const f32x4 v[2][2] = {{acc[ai][0][m][0], acc[ai][0][m][1]}, {acc[ai][1][m][0], acc[ai][1][m][1]}};
                e.row(u.pm * 256 + ai * 128 + wr * 64 + m * 16 + fr, u.pn, wc, fq, v);
            }
    }
};

template <class Epi>
__device__ __forceinline__ void skinny_phase(LAS unsigned char* lds, const bf16_t* A, const bf16_t* Bt, int K, int N, const Epi& E, int first_block) {
    const int bid = blockIdx.x, G = gridDim.x;
    if (bid < first_block) return;
    const int tid = threadIdx.x, w = tid >> 6, lane = tid & 63, fr = lane & 15, fq = lane >> 4, nb = G - first_block, nsu = (N / 64) * 8;
    const int nks = K / 256;
    for (int su = bid - first_block; su < nsu; su += nb) {
        const int rt = su & 7, pw = su >> 3, pn = pw >> 2, wc = pw & 3;
        const bf16_t* ap = A + (size_t)(NPR + 16 * rt + fr) * K + 8 * fq + w * nks * 32;
        const bf16_t* bp = Bt + (size_t)(pn * 256 + wc * 32 + fr) * K + 8 * fq + w * nks * 32;
        f32x4 acc[4];
#pragma unroll
        for (int i = 0; i < 4; ++i) acc[i] = (f32x4){0.f, 0.f, 0.f, 0.f};
        for (int ks = 0; ks < nks; ks += 2) {
            bf16x8 af[2], bf[2][4];
#pragma unroll
            for (int k2 = 0; k2 < 2; ++k2) {
                af[k2] = *(const bf16x8*)(ap + (ks + k2) * 32);
#pragma unroll
                for (int i = 0; i < 4; ++i) bf[k2][i] = *(const bf16x8*)(bp + (size_t)((i >> 1) * 128 + (i & 1) * 16) * K + (ks + k2) * 32);
            }
#pragma unroll
            for (int k2 = 0; k2 < 2; ++k2)
#pragma unroll
                for (int i = 0; i < 4; ++i) acc[i] = __builtin_amdgcn_mfma_f32_16x16x32_bf16(bf[k2][i], af[k2], acc[i], 0, 0, 0);
        }
        __syncthreads();
#pragma unroll
        for (int i = 0; i < 4; ++i) *(LAS f32x4*)(lds + (w * 4 + i) * 1024 + lane * 16) = acc[i];
        __syncthreads();
        if (w == 0) {
#pragma unroll
            for (int ww = 1; ww < 8; ++ww)
#pragma unroll
                for (int i = 0; i < 4; ++i) acc[i] += *(const LAS f32x4*)(lds + (ww * 4 + i) * 1024 + lane * 16);
            const f32x4 v[2][2] = {{acc[0], acc[1]}, {acc[2], acc[3]}};
            E.row(NPR + 16 * rt + fr, pn, wc, fq, v);
        }
    }
}

template <int KIND>
__device__ __forceinline__ const float* wsrc4(const float* w0, const float* w1, int p) {
    const int rho = p & 31, pb = p & ~31;
    if (KIND == 0) return w0 + pb + perm32(rho);
    if (KIND == 2) { const int pn = p >> 8, bj = (p >> 7) & 1, w = p & 127; const int off = pn * 128 + (w & ~31) + perm32(rho); const float* r0 = w0 + off; const float* r1 = w1 + off; return bj ? r1 : r0; }
    const int pn = p >> 8, bj = (p >> 7) & 1, w = p & 127, wc = w >> 5;
    if (pn < 8) return w0 + bj * 1024 + pn * 128 + wc * 32 + perm32(rho);
    if (pn < 20) return w0 + pb + (wc == 0 ? rho : perm32(rho));
    return w0 + pb + perm32(rho);
}
template <int KIND>
__device__ __forceinline__ void wcopy_unit(LAS float* tile, const float* w0, const float* w1, int ldw, int K, const float* kscale, bf16_t* dst, int kt, int pt) {
    const int tid = threadIdx.x, k0 = kt * 64, p0 = pt * 256;
    const int kk = tid >> 4, c4 = tid & 15;
    f32x4 v[4][2];
#pragma unroll
    for (int sbt = 0; sbt < 4; ++sbt) {
        const float* src = wsrc4<KIND>(w0, w1, p0 + sbt * 64 + 4 * c4);
#pragma unroll
        for (int i = 0; i < 2; ++i) v[sbt][i] = __builtin_nontemporal_load((const f32x4*)(src + (size_t)(k0 + kk + 32 * i) * ldw));
    }
#pragma unroll
    for (int sbt = 0; sbt < 4; ++sbt)
#pragma unroll
        for (int i = 0; i < 2; ++i) {
            f32x4 x = v[sbt][i];
            if (KIND == 2) x = x * kscale[k0 + kk + 32 * i];
            LAS float* d = tile + sbt * (64 * 65) + (kk + 32 * i) * 65 + 4 * c4; d[0] = x[0]; d[1] = x[1]; d[2] = x[2]; d[3] = x[3];
        }
    __syncthreads();
    const int pp = tid >> 3, kc = tid & 7;
#pragma unroll
    for (int sbt = 0; sbt < 4; ++sbt) {
        f32x4 a, b;
#pragma unroll
        for (int j = 0; j < 4; ++j) { a[j] = tile[sbt * (64 * 65) + (kc * 8 + j) * 65 + pp]; b[j] = tile[sbt * (64 * 65) + (kc * 8 + 4 + j) * 65 + pp]; }
        *(u32x4*)(dst + (size_t)(p0 + sbt * 64 + pp) * K + k0 + kc * 8) = pack8(a, b);
    }
    __syncthreads();
}

__constant__ double ROPE_INV[16] = {1.0, 0.44036660267178046, 0.19392274474868576, 0.08539710028576561, 0.03760603093086393, 0.016560440080994446, 0.007292664737217109, 0.003211445994752591,
                                    0.001414213562373095, 0.000622772421914596, 0.0002742481756762073, 0.00012076973741146504, 5.318295896944988e-05, 2.341999896140934e-05, 1.031338537721246e-05, 4.5416704806078695e-06};

constexpr int KSTR = 272, VOFF_LDS = 256 * KSTR;
__device__ __forceinline__ void attn_prompt_unit(LAS unsigned char* lds, int unit, const bf16_t* Qb, const bf16_t* Kb, const bf16_t* Vb, bf16_t* OG, float* LSE) {
    const int tid = threadIdx.x, w = __builtin_amdgcn_readfirstlane(tid >> 6), lane = tid & 63, fr = lane & 15, fq = lane >> 4;
    const int g = unit >> 8, rem = unit & 255, b = rem >> 6, hs = (rem >> 4) & 3, rb = rem & 15;
    const int sh = 2 * g, lnb = 4 - 2 * g, r = rb >> lnb, blk = rb & ((1 << lnb) - 1);
    const int head = 4 * g + hs;
    const size_t rowbase = (size_t)b * 2048 + r;
    __syncthreads();
#pragma unroll
    for (int it = 0; it < 8; ++it) {
        const int idx = tid + it * 512;
        const int key = idx >> 4, ch = idx & 15;
        int sp = (blk - 1) * 128 + key; if (sp < 0) sp += 128;
        const size_t off = (rowbase + ((size_t)sp << sh)) * AW + head * 128 + ch * 8;
        const u32x4 kv = *(const u32x4*)(Kb + off), vv = *(const u32x4*)(Vb + off);
        *(LAS u32x4*)(lds + key * KSTR + ch * 16) = kv;
        *(LAS u32x4*)(lds + VOFF_LDS + key * KSTR + ch * 16) = vv;
    }
    const int qi = 16 * w + fr;
    const size_t rowq = rowbase + ((size_t)(blk * 128 + qi) << sh);
    bf16x8 qf[4];
#pragma unroll
    for (int ks = 0; ks < 4; ++ks) qf[ks] = *(const bf16x8*)(Qb + rowq * AW + head * 128 + ks * 32 + fq * 8);
    __syncthreads();
    f32x4 sacc[10];
#pragma unroll
    for (int kt = 0; kt < 10; ++kt) {
        sacc[kt] = (f32x4){0.f, 0.f, 0.f, 0.f};
        const int tile = (w + kt) < 15 ? (w + kt) : 15;
#pragma unroll
        for (int ks = 0; ks < 4; ++ks) {
            const bf16x8 kf = *(const LAS bf16x8*)(lds + (tile * 16 + fr) * KSTR + (ks * 32 + fq * 8) * 2);
            sacc[kt] = __builtin_amdgcn_mfma_f32_16x16x32_bf16(kf, qf[ks], sacc[kt], 0, 0, 0);
        }
    }
    float mx = -INFINITY;
#pragma unroll
    for (int kt = 0; kt < 10; ++kt)
#pragma unroll
        for (int j = 0; j < 4; ++j) {
            const int ki = 16 * (w + kt) + 4 * fq + j, dist = 128 + qi - ki;
            const bool valid = (dist >= 0) && (dist <= 128) && (blk > 0 || ki >= 128);
            const float s = valid ? sacc[kt][j] * ATT_SCALE_LOG2E : -INFINITY;
            sacc[kt][j] = s; mx = fmaxf(mx, s);
        }
    mx = fmaxf(mx, __shfl_xor(mx, 16)); mx = fmaxf(mx, __shfl_xor(mx, 32));
    float den = 0.f;
#pragma unroll
    for (int kt = 0; kt < 10; ++kt)
#pragma unroll
        for (int j = 0; j < 4; ++j) { const float p = __builtin_amdgcn_exp2f(sacc[kt][j] - mx); sacc[kt][j] = p; den += p; }
    den += __shfl_xor(den, 16); den += __shfl_xor(den, 32);
    f32x4 oacc[8];
#pragma unroll
    for (int c = 0; c < 8; ++c) oacc[c] = (f32x4){0.f, 0.f, 0.f, 0.f};
    const int q4 = fr >> 2, p4 = fr & 3;
#pragma unroll
    for (int s = 0; s < 5; ++s) {
        bf16x8 pf; u32x4 pw; pw.x = cvt_pk_bf16(sacc[2 * s][0], sacc[2 * s][1]); pw.y = cvt_pk_bf16(sacc[2 * s][2], sacc[2 * s][3]);
        pw.z = cvt_pk_bf16(sacc[2 * s + 1][0], sacc[2 * s + 1][1]); pw.w = cvt_pk_bf16(sacc[2 * s + 1][2], sacc[2 * s + 1][3]);
        pf = __builtin_bit_cast(bf16x8, pw);
        const int t0 = (w + 2 * s) < 15 ? (w + 2 * s) : 15, t1 = (w + 2 * s + 1) < 15 ? (w + 2 * s + 1) : 15;
        const unsigned a0 = VOFF_LDS + (t0 * 16 + 4 * fq + q4) * KSTR + p4 * 8, a1 = VOFF_LDS + (t1 * 16 + 4 * fq + q4) * KSTR + p4 * 8;
#pragma unroll
        for (int c = 0; c < 8; ++c) {
            const s16x4 v0 = __builtin_amdgcn_ds_read_tr16_b64_v4i16((LAS s16x4*)(lds + a0 + c * 32));
            const s16x4 v1 = __builtin_amdgcn_ds_read_tr16_b64_v4i16((LAS s16x4*)(lds + a1 + c * 32));
            bf16x8 vf; vf[0] = v0[0]; vf[1] = v0[1]; vf[2] = v0[2]; vf[3] = v0[3]; vf[4] = v1[0]; vf[5] = v1[1]; vf[6] = v1[2]; vf[7] = v1[3];
            oacc[c] = __builtin_amdgcn_mfma_f32_16x16x32_bf16(vf, pf, oacc[c], 0, 0, 0);
        }
    }
    const float inv = 1.0f / den;
    bf16_t* dst = OG + ((size_t)g * MP + rowq) * AO + hs * 128 + 4 * fq;
#pragma unroll
    for (int c = 0; c < 8; ++c) { u32x2 wv; wv.x = cvt_pk_bf16(oacc[c][0] * inv, oacc[c][1] * inv); wv.y = cvt_pk_bf16(oacc[c][2] * inv, oacc[c][3] * inv); *(u32x2*)(dst + c * 16) = wv; }
    if (fq == 0) LSE[((size_t)g * MP + rowq) * 4 + hs] = (mx + __builtin_amdgcn_logf(den)) * LN2F;
}

__device__ __forceinline__ void attn_sample_unit(int unit, const Args& a, const bf16_t* Qb, bf16_t* OG, float* LSE) {
    const int tid = threadIdx.x, w = tid >> 6, lane = tid & 63, sub = lane & 15, kq = lane >> 4;
    const int idx = unit * 8 + w, b = idx / 48, rem = idx % 48, t = rem / 12, head = rem % 12, g = head >> 2, hs = head & 3, dil = 1 << (2 * g), Wb = 128 * dil;
    const float* ck = g == 0 ? a.in[3] : (g == 1 ? a.in[5] : a.in[7]); const float* cv = g == 0 ? a.in[4] : (g == 1 ? a.in[6] : a.in[8]);
    const float* ok = a.out + kv_group_base(g) + (size_t)4 * Wb * 512; const float* ov = a.out + kv_group_base(g) + (size_t)40 * Wb * 512;
    const size_t row = (size_t)NPR + b * 4 + t, bbase = (size_t)b * Wb * 512 + hs * 128 + 8 * sub;
    f32x4 q0, q1; unpack8(*(const u32x4*)(Qb + row * AW + head * 128 + 8 * sub), q0, q1);
    float m = -INFINITY, l = 0.f; f32x4 o0 = (f32x4){0.f, 0.f, 0.f, 0.f}, o1 = o0;
#pragma unroll 3
    for (int i = 0; i < 33; ++i) {
        const int j = 4 * i + kq; const bool valid = j <= 128;
        const int ci = Wb + t - (valid ? j : 128) * dil;
        const bool fresh = ci >= Wb;
        const float* kp = (fresh ? ok + (size_t)(ci - 4) * 512 : ck + (size_t)ci * 512) + bbase;
        const float* vp = (fresh ? ov + (size_t)(ci - 4) * 512 : cv + (size_t)ci * 512) + bbase;
        const f32x4 k0 = *(const f32x4*)kp, k1 = *(const f32x4*)(kp + 4), v0 = *(const f32x4*)vp, v1 = *(const f32x4*)(vp + 4);
        float s = q0[0] * k0[0] + q0[1] * k0[1] + q0[2] * k0[2] + q0[3] * k0[3] + q1[0] * k1[0] + q1[1] * k1[1] + q1[2] * k1[2] + q1[3] * k1[3];
        s += __shfl_xor(s, 1); s += __shfl_xor(s, 2); s += __shfl_xor(s, 4); s += __shfl_xor(s, 8);
        s = valid ? s * ATT_SCALE_LOG2E : -INFINITY;
        const float mn = fmaxf(m, s), sc = __builtin_amdgcn_exp2f(m - mn), p = __builtin_amdgcn_exp2f(s - mn);
        l = l * sc + p; o0 = o0 * sc + v0 * p; o1 = o1 * sc + v1 * p; m = mn;
    }
#pragma unroll
    for (int x = 16; x <= 32; x <<= 1) {
        const float m2 = __shfl_xor(m, x), l2 = __shfl_xor(l, x);
        f32x4 p0, p1;
#pragma unroll
        for (int e = 0; e < 4; ++e) { p0[e] = __shfl_xor(o0[e], x); p1[e] = __shfl_xor(o1[e], x); }
        const float mn = fmaxf(m, m2), s1 = __builtin_amdgcn_exp2f(m - mn), s2 = __builtin_amdgcn_exp2f(m2 - mn);
        l = l * s1 + l2 * s2; o0 = o0 * s1 + p0 * s2; o1 = o1 * s1 + p1 * s2; m = mn;
    }
    if (kq == 0) {
        const float inv = 1.0f / l;
        *(u32x4*)(OG + ((size_t)g * MP + row) * AO + hs * 128 + 8 * sub) = pack8(o0 * inv, o1 * inv);
        if (sub == 0) LSE[((size_t)g * MP + row) * 4 + hs] = (m + __builtin_amdgcn_logf(l)) * LN2F;
    }
}

__device__ __forceinline__ void conv_unit(LAS unsigned char* lds, int unit, const Args& a, const bf16_t* U, bf16_t* CACT, const f32x2 (&wd)[31], const f32x2 bdw, const f32x2 lng, const f32x2 lnb) {
    const int tid = threadIdx.x, wid = tid >> 6, lane = tid & 63;
    const bool prompt = unit < 512;
    const int b = prompt ? unit >> 7 : unit - 512, t0 = prompt ? (unit & 127) * 16 : 0, ntok = prompt ? 16 : 4, nrows = ntok + 30;
    const size_t row0 = prompt ? (size_t)b * 2048 + t0 : (size_t)NPR + b * 4;
    __syncthreads();
    if (prompt) {
#pragma unroll
        for (int it = 0; it < 12; ++it) {
            const int idx = tid + it * 512, rr = idx >> 7, ch = idx & 127, tt = t0 - 30 + rr;
            if (it < 11 || idx < 46 * 128) {
                u32x4 v = *(const u32x4*)(U + ((size_t)b * 2048 + (tt < 0 ? 0 : tt)) * DC + ch * 8);
                if (tt < 0) v = (u32x4){0u, 0u, 0u, 0u};
                *(LAS u32x4*)(lds + rr * 2048 + ch * 16) = v;
            }
        }
    } else {
        for (int idx = tid; idx < nrows * 128; idx += 512) {
            const int rr = idx >> 7, ch = idx & 127;
            u32x4 v;
            if (rr < 30) { const float* sp_ = a.in[2] + ((size_t)b * 30 + rr) * 1024 + ch * 8; v = pack8(*(const f32x4*)sp_, *(const f32x4*)(sp_ + 4)); }
            else v = *(const u32x4*)(U + (row0 + rr - 30) * DC + ch * 8);
            *(LAS u32x4*)(lds + rr * 2048 + ch * 16) = v;
        }
    }
    __syncthreads();
    f32x2 y[16];
#pragma unroll
    for (int i = 0; i < 16; ++i) y[i] = bdw;
#pragma unroll
    for (int rr = 0; rr < 46; ++rr) {
        const unsigned xw = *(const LAS unsigned*)(lds + rr * 2048 + tid * 4);
        const f32x2 x = (f32x2){bf_lo(xw), bf_hi(xw)};
#pragma unroll
        for (int i = 0; i < 16; ++i) { const int j = rr - i; if (j >= 0 && j <= 30) y[i] += wd[j] * x; }
    }
    LAS float* red = (LAS float*)(lds + 96 * 1024);
#pragma unroll
    for (int i = 0; i < 16; ++i) {
        float s1 = y[i][0] + y[i][1], s2 = y[i][0] * y[i][0] + y[i][1] * y[i][1];
#pragma unroll
        for (int o = 1; o < 64; o <<= 1) { s1 += __shfl_xor(s1, o); s2 += __shfl_xor(s2, o); }
        if (lane == 0) { red[wid * 32 + 2 * i] = s1; red[wid * 32 + 2 * i + 1] = s2; }
    }
    __syncthreads();
    if (tid < 32) { float s = 0.f;
#pragma unroll
        for (int ww = 0; ww < 8; ++ww) s += red[ww * 32 + tid];
        red[256 + tid] = s; }
    __syncthreads();
#pragma unroll
    for (int i = 0; i < 16; ++i) {
        if (i < ntok) {
            const float mu = red[256 + 2 * i] * (1.0f / DC), var = red[256 + 2 * i + 1] * (1.0f / DC) - mu * mu, rs = __builtin_amdgcn_rsqf(var + LN_EPS);
            const float z0 = (y[i][0] - mu) * rs * lng[0] + lnb[0], z1 = (y[i][1] - mu) * rs * lng[1] + lnb[1];
            *(unsigned*)(CACT + (row0 + i) * DC + tid * 2) = cvt_pk_bf16(z0 * sigmoidf_(z0), z1 * sigmoidf_(z1));
        }
    }
}

#define XB_TMO      128
#define XB_XCNT(j)  (256  + 64 * (j))
#define XB_XSUB(j)  (1280 + 64 * (j))
#define XB_XGEN(j)  (2304 + 64 * (j))
#define XB_TOP      3328
#define XB_TOPGEN   3392
#define XCD_BAR_WORDS 3456
#define XB_SPIN_CAP (1u << 18)
__device__ __forceinline__ unsigned xb_ld(unsigned* p)              { return __hip_atomic_load(p, __ATOMIC_RELAXED, __HIP_MEMORY_SCOPE_AGENT); }
__device__ __forceinline__ unsigned xb_add(unsigned* p, unsigned v) { return __hip_atomic_fetch_add(p, v, __ATOMIC_RELAXED, __HIP_MEMORY_SCOPE_AGENT); }
__device__ __forceinline__ unsigned xb_xcc_id() { return (unsigned)__builtin_amdgcn_s_getreg((3 << 11) | 20) & 0xFu; }
#define XB_SPIN(cond, bar) do { unsigned _sp = 0; while (cond) { __builtin_amdgcn_s_sleep(1); \
    if ((++_sp & 255u) == 0u) { if (xb_ld(&(bar)[XB_TMO])) break; if (_sp > XB_SPIN_CAP) { atomicAdd(&(bar)[XB_TMO], 1u); break; } } } } while (0)
struct XcdBarrier { unsigned* bar; unsigned x; volatile LAS unsigned* st; };
__device__ __forceinline__ XcdBarrier xcd_barrier_post(unsigned* bar, volatile LAS unsigned* st) {
    XcdBarrier b; b.bar = bar; b.x = xb_xcc_id(); b.st = st;
    if (threadIdx.x == 0) (void)xb_add(&bar[XB_XCNT(b.x)], 1u);
    return b;
}
__device__ __forceinline__ void xcd_barrier_complete(unsigned* bar, unsigned x, unsigned& nloc, unsigned& nx) {
    const unsigned G = gridDim.x * gridDim.y * gridDim.z;
    unsigned sum, cnt, mine, sp = 0u;
    for (;;) {
        sum = 0u; cnt = 0u; mine = 0u;
#pragma unroll
        for (unsigned j = 0; j < 16; ++j) { const unsigned c = xb_ld(&bar[XB_XCNT(j)]); sum += c; cnt += (c > 0u) ? 1u : 0u; mine = (j == x) ? c : mine; }
        if (sum == G) break;
        __builtin_amdgcn_s_sleep(1);
        if ((++sp & 255u) == 0u) { if (xb_ld(&bar[XB_TMO])) break; if (sp > XB_SPIN_CAP) { atomicAdd(&bar[XB_TMO], 1u); break; } }
    }
    nloc = mine > 0u ? mine : 1u; nx = cnt > 0u ? cnt : 1u;
}
__device__ __forceinline__ void xcd_barrier(const XcdBarrier& b) {
    asm volatile("s_waitcnt vmcnt(0)" ::: "memory");
    __syncthreads();
    if (threadIdx.x == 0) {
        unsigned* bar = b.bar;
        __builtin_amdgcn_s_waitcnt(0);
        unsigned nloc = b.st[0], nx = b.st[1];
        if (nloc == 0u) { xcd_barrier_complete(bar, b.x, nloc, nx); b.st[0] = nloc; b.st[1] = nx; }
        const unsigned old = xb_add(&bar[XB_XSUB(b.x)], 1u);
        const unsigned gen = old / nloc;
        if (old + 1u == (gen + 1u) * nloc) {
            __builtin_amdgcn_fence(__ATOMIC_RELEASE, "agent");
            asm volatile("s_waitcnt vmcnt(0)" ::: "memory");
            const unsigned og = xb_add(&bar[XB_TOP], 1u);
            const unsigned tg = og / nx;
            if (og + 1u == (tg + 1u) * nx) xb_add(&bar[XB_TOPGEN], 1u);
            else XB_SPIN(xb_ld(&bar[XB_TOPGEN]) == tg, bar);
            __builtin_amdgcn_fence(__ATOMIC_ACQUIRE, "agent");
            xb_add(&bar[XB_XGEN(b.x)], 1u);
            asm volatile("s_waitcnt vmcnt(0)" ::: "memory");
        } else {
            XB_SPIN(xb_ld(&bar[XB_XGEN(b.x)]) == gen, bar);
            __builtin_amdgcn_fence(__ATOMIC_ACQUIRE, "agent");
            asm volatile("s_waitcnt vmcnt(0)" ::: "memory");
        }
    }
    __syncthreads();
}

__global__ void __launch_bounds__(512, 2) mega(Args a) {
    extern __shared__ __attribute__((aligned(16))) unsigned char shm[];
    LAS unsigned char* lds = (LAS unsigned char*)shm;
    cg::grid_group grid = cg::this_grid();
    const int tid = threadIdx.x, wid = tid >> 6, lane = tid & 63, G = gridDim.x, bid = blockIdx.x;
    unsigned char* ws = a.ws; unsigned* ctl = (unsigned*)(ws + WS_CTL);
    bf16_t* XA = (bf16_t*)(ws + WS_XA); bf16_t* T1 = (bf16_t*)(ws + WS_T1); bf16_t* MIX = (bf16_t*)(ws + WS_MIX); float* X1 = (float*)(ws + WS_X1);
    bf16_t* U = (bf16_t*)(ws + WS_U); bf16_t* Qb = (bf16_t*)(ws + WS_Q); bf16_t* Kb = (bf16_t*)(ws + WS_K); bf16_t* Vb = (bf16_t*)(ws + WS_V);
    bf16_t* GC = (bf16_t*)(ws + WS_GC); bf16_t* GA = (bf16_t*)(ws + WS_GA); bf16_t* CACT = (bf16_t*)(ws + WS_CACT); bf16_t* OG = (bf16_t*)(ws + WS_OG); bf16_t* OATT = (bf16_t*)(ws + WS_OATT);
    bf16_t* HID = (bf16_t*)(ws + WS_HID); float* SS1 = (float*)(ws + WS_SS1); float* SS2 = (float*)(ws + WS_SS2); float* ROPE = (float*)(ws + WS_ROPE); float* LSE = (float*)(ws + WS_LSE);
#define PH(p) if (a.ph_lo <= (p) && (p) < a.ph_hi)
#define SEAM(p) if (a.ph_lo <= (p) && (p) + 1 < a.ph_hi) xcd_barrier(xb)

    volatile LAS unsigned* xst = (volatile LAS unsigned*)(lds + LDS_BYTES - 16);
    if (tid == 0) { xst[0] = 0u; xst[1] = 0u; LAS unsigned long long* pt = (LAS unsigned long long*)(lds + LDS_BYTES - 128);
        pt[0] = (unsigned long long)a.in[3]; pt[1] = (unsigned long long)a.in[4]; pt[2] = (unsigned long long)a.in[5]; pt[3] = (unsigned long long)a.in[6]; pt[4] = (unsigned long long)a.in[7]; pt[5] = (unsigned long long)a.in[8]; }
    CacheStream cs; cs.ci = 0; cs.c = bid; cs.step = G; cs.out = a.out; cs.sbase = nullptr; cs.dbase = nullptr; cs.ncache = 0; cs.cur_src = nullptr; cs.cur_dst = nullptr; cs.inflight = false; cs.ready = false; NoStream ns;
    __syncthreads();
    cs.setup(lds);
    XcdBarrier xb = xcd_barrier_post((unsigned*)(ws + WS_CTL), xst);
    if (a.ph_hi > 1000) grid.sync();
    PH(0) {
        const int gt = bid * 512 + tid, GT = G * 512;
        for (int i = gt; i < 2 * 16384; i += GT) __hip_atomic_store((float*)(ws + WS_SS1) + i, 0.f, __ATOMIC_RELAXED, __HIP_MEMORY_SCOPE_AGENT);
        for (int i = gt; i < 2052 * 16; i += GT) {
            const int pi = i >> 4, fi = i & 15; const double pos = pi < 2048 ? (double)pi : (double)(8192 + pi - 2048);
            const double rev = pos * ROPE_INV[fi] * 0.15915494309189535; const float fr_ = (float)(rev - floor(rev));
            ROPE[2 * i] = __builtin_amdgcn_cosf(fr_); ROPE[2 * i + 1] = __builtin_amdgcn_sinf(fr_);
        }
        for (int row = bid * 8 + wid; row < MR; row += G * 8) {
            const float* src = row < NPR ? a.in[0] + (size_t)row * DM : a.in[1] + (size_t)(row - NPR) * DM;
            f32x4 v[8]; float ss = 0.f;
#pragma unroll
            for (int i = 0; i < 4; ++i) { v[2 * i] = *(const f32x4*)(src + (i * 64 + lane) * 8); v[2 * i + 1] = *(const f32x4*)(src + (i * 64 + lane) * 8 + 4); }
#pragma unroll
            for (int i = 0; i < 8; ++i) ss += v[i][0] * v[i][0] + v[i][1] * v[i][1] + v[i][2] * v[i][2] + v[i][3] * v[i][3];
#pragma unroll
            for (int o = 1; o < 64; o <<= 1) ss += __shfl_xor(ss, o);
            const float r = __builtin_amdgcn_rsqf(ss * (1.0f / DM) + NORM_EPS);
#pragma unroll
            for (int i = 0; i < 4; ++i) { const int c = (i * 64 + lane) * 8; const f32x4 g0 = *(const f32x4*)(a.in[9] + c), g1 = *(const f32x4*)(a.in[9] + c + 4);
                *(u32x4*)(XA + (size_t)row * DM + c) = pack8(v[2 * i] * r * g0, v[2 * i + 1] * r * g1); }
        }
        {
#define WCOPY(KIND, w0, w1, ldw, K, Np, ksc, dst) do { const int npt_ = (Np) / 256, nu_ = ((K) / 64) * npt_; \
                for (int uidx = bid; uidx < nu_; uidx += G) wcopy_unit<KIND>((LAS float*)lds, w0, w1, ldw, K, ksc, dst, uidx / npt_, uidx % npt_); } while (0)
            WCOPY(1, a.in[10], nullptr, INC, DM, INC, nullptr, (bf16_t*)(ws + WS_WIN));
            WCOPY(0, a.in[16], nullptr, DM, DC, DM, nullptr, (bf16_t*)(ws + WS_WPW));
            WCOPY(0, a.in[18], nullptr, DM, AO, DM, nullptr, (bf16_t*)(ws + WS_WOA));
            WCOPY(0, a.in[19], nullptr, DM, DM, DM, nullptr, (bf16_t*)(ws + WS_WOUT));
            WCOPY(2, a.in[21], a.in[22], FH, DM, 2 * FH, a.in[20], (bf16_t*)(ws + WS_WGU));
            WCOPY(0, a.in[23], nullptr, DM, FH, DM, nullptr, (bf16_t*)(ws + WS_WDN));
#undef WCOPY
        }
        for (int i = gt; i < 32 * 26 * 256; i += GT) { const int bb = i / (26 * 256), rr = i - bb * 26 * 256; ((f32x4*)(a.out + OFF_CONVS))[(size_t)bb * 30 * 256 + rr] = ((const f32x4*)a.in[2])[(size_t)bb * 30 * 256 + 4 * 256 + rr]; }
    }
    SEAM(0);
    PH(1) {
        pg8::Gemm gm{XA, (const bf16_t*)(ws + WS_WIN), NPR, INC, DM};
        pg8::StaticOrder S; S.init(NPR, INC, G, bid);
        TileEpi<EpiIn> E{EpiIn{U, Qb, Kb, Vb, GC, GA, a.out, a.in[11], ROPE}};
        pg8::gemm_phase(lds, gm, S, E, cs);
        skinny_phase(lds, XA, (const bf16_t*)(ws + WS_WIN), DM, INC, E.e, 64);
    }
    SEAM(1);
    PH(2) {
        {
            const int nmine = (768 + 192 - bid + G - 1) / G;
            for (int i = 0; i < nmine; ++i) {
                const int k = (i + bid) % nmine, u = bid + k * G;
                if (u < 768) attn_prompt_unit(lds, u, Qb, Kb, Vb, OG, LSE);
                else attn_sample_unit(u - 768, a, Qb, OG, LSE);
            }
        }
        if (bid < 544) {
            f32x2 wd[31];
#pragma unroll
            for (int j = 0; j < 31; ++j) wd[j] = *(const f32x2*)(a.in[12] + j * 1024 + tid * 2);
            const f32x2 bdw = *(const f32x2*)(a.in[13] + tid * 2), lng = *(const f32x2*)(a.in[14] + tid * 2), lnb = *(const f32x2*)(a.in[15] + tid * 2);
            for (int u = G - 1 - bid; u < 544; u += G) conv_unit(lds, u, a, U, CACT, wd, bdw, lng, lnb);
        }
    }
    SEAM(2);
    PH(3) {
        for (int u = bid; u < MR / 32; u += G) {
#pragma unroll
            for (int i = 0; i < 4; ++i) {
                const int idx = tid + 512 * i, row = u * 32 + (idx >> 6), ch = idx & 63, hs = ch >> 4;
                const float l0 = LSE[((size_t)0 * MP + row) * 4 + hs], l1 = LSE[((size_t)1 * MP + row) * 4 + hs], l2 = LSE[((size_t)2 * MP + row) * 4 + hs];
                const float mx = fmaxf(l0, fmaxf(l1, l2)), e0 = __expf(l0 - mx), e1 = __expf(l1 - mx), e2 = __expf(l2 - mx), inv = 1.0f / (e0 + e1 + e2);
                f32x4 a0, b0, a1, b1, a2, b2;
                unpack8(*(const u32x4*)(OG + ((size_t)0 * MP + row) * AO + ch * 8), a0, b0);
                unpack8(*(const u32x4*)(OG + ((size_t)1 * MP + row) * AO + ch * 8), a1, b1);
                unpack8(*(const u32x4*)(OG + ((size_t)2 * MP + row) * AO + ch * 8), a2, b2);
                *(u32x4*)(OATT + (size_t)row * AO + ch * 8) = pack8((a0 * e0 + a1 * e1 + a2 * e2) * inv, (b0 * e0 + b1 * e1 + b2 * e2) * inv);
            }
        }
    }
    SEAM(3);
    PH(4) {
        pg8::StaticOrder S; S.init(NPR, DM, G, bid);
        TileEpi<EpiPw> E1{EpiPw{T1, GC, a.in[17]}}; TileEpi<EpiOa> E2{EpiOa{T1, GA, MIX}};
        { pg8::Gemm gm{CACT, (const bf16_t*)(ws + WS_WPW), NPR, DM, DC}; pg8::gemm_phase(lds, gm, S, E1, ns); }
        { pg8::Gemm gm{OATT, (const bf16_t*)(ws + WS_WOA), NPR, DM, AO}; pg8::gemm_phase(lds, gm, S, E2, ns); }
        skinny_phase(lds, CACT, (const bf16_t*)(ws + WS_WPW), DC, DM, E1.e, 0);
        skinny_phase(lds, OATT, (const bf16_t*)(ws + WS_WOA), AO, DM, E2.e, 0);
    }
    SEAM(4);
    PH(5) {
        pg8::Gemm gm{MIX, (const bf16_t*)(ws + WS_WOUT), NPR, DM, DM};
        pg8::StaticOrder S; S.init(NPR, DM, G, bid);
        TileEpi<EpiRes> E{EpiRes{a.in[0], a.in[1], (size_t)NPR, nullptr, XA, SS1, nullptr}};
        pg8::gemm_phase(lds, gm, S, E, ns);
        skinny_phase(lds, MIX, (const bf16_t*)(ws + WS_WOUT), DM, DM, E.e, 0);
    }
    SEAM(5);
    PH(6) {
        pg8::Gemm gm{XA, (const bf16_t*)(ws + WS_WGU), NPR, 2 * FH, DM};
        pg8::StaticOrder S; S.init(NPR, 2 * FH, G, bid);
        TileEpi<EpiGu> E{EpiGu{SS1, HID}};
        pg8::gemm_phase(lds, gm, S, E, cs);
        skinny_phase(lds, XA, (const bf16_t*)(ws + WS_WGU), DM, 2 * FH, E.e, 128);
    }
    SEAM(6);
    PH(7) {
        pg8::Gemm gm{HID, (const bf16_t*)(ws + WS_WDN), NPR, DM, FH};
        pg8::StaticOrder S; S.init(NPR, DM, G, bid);
        TileEpi<EpiRes> E{EpiRes{nullptr, nullptr, (size_t)0, a.out, nullptr, SS2, XA}};
        if (G == 256) {
            EpiFinalTile EF{XA, a.out, SS2, ctl, a.in[24]}; pg8::gemm_phase(lds, gm, S, EF, ns);
            EpiFinalRow ER{XA, a.out, SS2, ctl, a.in[24]}; skinny_phase(lds, HID, (const bf16_t*)(ws + WS_WDN), FH, DM, ER, 0);
        } else {
            pg8::gemm_phase(lds, gm, S, E, ns);
            skinny_phase(lds, HID, (const bf16_t*)(ws + WS_WDN), FH, DM, E.e, 0);
        }
        if (cs.ready) { __builtin_nontemporal_store(__builtin_nontemporal_load((const f32x4*)(cs.cur_src + tid * 4)), (f32x4*)(cs.cur_dst + tid * 4)); cs.ready = false; }
        while (cs.ci < 6) {
            f32x4 v[8]; float* d[8];
#pragma unroll
            for (int k = 0; k < 8; ++k) { d[k] = nullptr; if (cs.ci < 6) { cs.decode_next(lds); d[k] = cs.cur_dst; v[k] = __builtin_nontemporal_load((const f32x4*)(cs.cur_src + tid * 4)); } }
#pragma unroll
            for (int k = 0; k < 8; ++k) if (d[k]) __builtin_nontemporal_store(v[k], (f32x4*)(d[k] + tid * 4));
        }
    }
    if (G != 256) {
    SEAM(7);
    PH(8) {
        for (int row = bid * 8 + wid; row < MR; row += G * 8) {
            float* p = a.out + (size_t)row * DM;
            const float r = __builtin_amdgcn_rsqf(SS2[row] * (1.0f / DM) + NORM_EPS);
#pragma unroll
            for (int i = 0; i < 8; ++i) { const int c = (i * 64 + lane) * 4; *(f32x4*)(p + c) = *(const f32x4*)(p + c) * r * *(const f32x4*)(a.in[24] + c); }
        }
    }
    }
}

extern "C" void kernel_launch(void* const* d_in, const int* in_sizes, int n_in, void* d_out, int out_size, void* d_ws, size_t ws_size, hipStream_t stream) {
    static int grid = 0;
    if (grid == 0) {
        if (n_in != 25 || ws_size < WS_END) { fprintf(stderr, "kernel_launch: need 25 inputs and %zu bytes of workspace; got %d, %zu\n", (size_t)WS_END, n_in, ws_size); grid = -1; return; }
        int dev = 0, cus = 0, per_cu = 0;
        (void)hipGetDevice(&dev); (void)hipDeviceGetAttribute(&cus, hipDeviceAttributeMultiprocessorCount, dev);
        if (hipFuncSetAttribute((const void*)mega, hipFuncAttributeMaxDynamicSharedMemorySize, LDS_BYTES) != hipSuccess) { fprintf(stderr, "kernel_launch: hipFuncSetAttribute failed\n"); grid = -1; return; }
        if (hipOccupancyMaxActiveBlocksPerMultiprocessor(&per_cu, (const void*)mega, 512, LDS_BYTES) != hipSuccess || per_cu < 1) { fprintf(stderr, "kernel_launch: occupancy query says %d\n", per_cu); per_cu = 1; }
        (void)hipGetLastError();
        grid = cus * 1;
        if (grid > 512) grid = 512;
    }
    if (grid < 0) return;
    (void)hipMemsetAsync((char*)d_ws + WS_CTL, 0, 40960, stream);
    Args a{};
    for (int i = 0; i < 25; ++i) a.in[i] = (const float*)d_in[i];
    a.out = (float*)d_out; a.ws = (unsigned char*)d_ws;
#if MK_SPLIT
    for (int p = 0; p < 9; ++p) { a.ph_lo = p; a.ph_hi = p + 1; hipLaunchKernelGGL(mega, dim3(grid), dim3(512), LDS_BYTES, stream, a); }
#else
    a.ph_lo = 0; a.ph_hi = 9;
    void* args[] = {&a};
    hipError_t e = hipLaunchCooperativeKernel((const void*)mega, dim3(grid), dim3(512), args, LDS_BYTES, stream);
    if (e != hipSuccess) fprintf(stderr, "kernel_launch: cooperative launch failed: %s (grid %d)\n", hipGetErrorString(e), grid);
#endif
}
```

```cpp
#include <hip/hip_runtime.h>
#include <hip/hip_cooperative_groups.h>
#include <cstdio>
#include <cstdint>
namespace cg = cooperative_groups;

#ifndef MK_SPLIT
#define MK_SPLIT 0
#endif

#define LAS __attribute__((address_space(3)))
typedef unsigned short bf16_t;
typedef short bf16x8 __attribute__((ext_vector_type(8)));
typedef short s16x4 __attribute__((ext_vector_type(4)));
typedef float f32x4 __attribute__((ext_vector_type(4)));
typedef float f32x2 __attribute__((ext_vector_type(2)));
typedef unsigned u32x4 __attribute__((ext_vector_type(4)));
typedef unsigned u32x2 __attribute__((ext_vector_type(2)));

constexpr int DM = 2048, NPR = 8192, MR = 8320, MP = 8448;
constexpr int DC = 1024, AW = 1536, AO = 512, FH = 5632, INC = 10752;
constexpr float NORM_EPS = 1e-6f, LN_EPS = 1e-5f;
constexpr float ATT_SCALE_LOG2E = 0.08838834764831845f * 1.4426950408889634f;
constexpr float LN2F = 0.6931471805599453f;

constexpr size_t OFF_YP = 0, OFF_YS = (size_t)NPR * DM, OFF_CONVP = (size_t)MR * DM, OFF_CONVS = OFF_CONVP + 4 * 30 * 1024, OFF_KV = OFF_CONVS + 32 * 30 * 1024;
__host__ __device__ constexpr size_t kv_group_base(int g) { return OFF_KV + (g == 0 ? 0 : (g == 1 ? (size_t)2 * 36 * 128 * 512 : (size_t)2 * 36 * (128 + 512) * 512)); }

constexpr size_t MiB = 1u << 20;
constexpr size_t WS_CTL = 0;
constexpr size_t WS_SS1 = 1 * MiB, WS_SS2 = WS_SS1 + 64 * 1024;
constexpr size_t WS_ROPE = 2 * MiB;
constexpr size_t WS_LSE = 3 * MiB;
constexpr size_t WS_WIN = 4 * MiB;
constexpr size_t WS_WPW = WS_WIN + (size_t)INC * DM * 2;
constexpr size_t WS_WOA = WS_WPW + (size_t)DM * DC * 2;
constexpr size_t WS_WOUT = WS_WOA + (size_t)DM * AO * 2;
constexpr size_t WS_WGU = WS_WOUT + (size_t)DM * DM * 2;
constexpr size_t WS_WDN = WS_WGU + (size_t)2 * FH * DM * 2;
constexpr size_t WS_XA = WS_WDN + (size_t)DM * FH * 2;
constexpr size_t WS_T1 = WS_XA + (size_t)MP * DM * 2;
constexpr size_t WS_MIX = WS_T1 + (size_t)MP * DM * 4;
constexpr size_t WS_X1 = WS_MIX + (size_t)MP * DM * 2;
constexpr size_t WS_C = WS_X1 + (size_t)MP * DM * 4;
constexpr size_t WS_U = WS_C;
constexpr size_t WS_Q = WS_U + (size_t)MP * DC * 2;
constexpr size_t WS_K = WS_Q + (size_t)MP * AW * 2;
constexpr size_t WS_V = WS_K + (size_t)MP * AW * 2;
constexpr size_t WS_GC = WS_V + (size_t)MP * AW * 2;
constexpr size_t WS_GA = WS_GC + (size_t)MP * DM * 2;
constexpr size_t WS_CACT = WS_GA + (size_t)MP * DM * 2;
constexpr size_t WS_OG = WS_CACT + (size_t)MP * DC * 2;
constexpr size_t WS_OATT = WS_OG + (size_t)3 * MP * AO * 2;
constexpr size_t WS_CEND = WS_OATT + (size_t)MP * AO * 2;
constexpr size_t WS_HID = WS_C;
static_assert(WS_HID + (size_t)MP * FH * 2 <= WS_CEND, "HID overlay fits region C");
constexpr size_t WS_END = WS_CEND;

constexpr int LDS_BYTES = 147456;

struct Args { const float* in[25]; float* out; unsigned char* ws; int ph_lo, ph_hi; };

__device__ __forceinline__ unsigned cvt_pk_bf16(float lo, float hi) { unsigned r; asm("v_cvt_pk_bf16_f32 %0, %1, %2" : "=v"(r) : "v"(lo), "v"(hi)); return r; }
__device__ __forceinline__ float bf_lo(unsigned w) { return __uint_as_float(w << 16); }
__device__ __forceinline__ float bf_hi(unsigned w) { return __uint_as_float(w & 0xffff0000u); }
__device__ __forceinline__ float sigmoidf_(float x) { return __builtin_amdgcn_rcpf(1.0f + __expf(-x)); }
__device__ __forceinline__ u32x4 pack8(const f32x4& a, const f32x4& b) { u32x4 w; w.x = cvt_pk_bf16(a[0], a[1]); w.y = cvt_pk_bf16(a[2], a[3]); w.z = cvt_pk_bf16(b[0], b[1]); w.w = cvt_pk_bf16(b[2], b[3]); return w; }
__device__ __forceinline__ void unpack8(const u32x4& w, f32x4& a, f32x4& b) { a[0] = bf_lo(w.x); a[1] = bf_hi(w.x); a[2] = bf_lo(w.y); a[3] = bf_hi(w.y); b[0] = bf_lo(w.z); b[1] = bf_hi(w.z); b[2] = bf_lo(w.w); b[3] = bf_hi(w.w); }
__host__ __device__ __forceinline__ int perm32(int rho) { const int n = rho >> 4, i = rho & 15; return 8 * (i >> 2) + 4 * n + (i & 3); }

constexpr int CS_NCHUNK = 42816, CS_LDS_OFF = 131072;
struct CacheStream {
    int ci, c, step;
    const float* out;
    const float* sbase; float* dbase; int ncache;
    const float* cur_src; float* cur_dst;
    bool inflight;
    __device__ __forceinline__ void setup(LAS unsigned char* lds) {
        while (ci < 6) { const int cpb = (32 << (2 * (ci >> 1))) - 1; ncache = 32 * cpb; if (c < ncache) break; c -= ncache; ++ci; }
        if (ci < 6) {
            const int g = ci >> 1, Wb = 128 << (2 * g);
            const unsigned long long sp = ((const LAS unsigned long long*)(lds + LDS_BYTES - 128))[ci];
            const unsigned lo = __builtin_amdgcn_readfirstlane((unsigned)sp), hi = __builtin_amdgcn_readfirstlane((unsigned)(sp >> 32));
            sbase = (const float*)(((unsigned long long)hi << 32) | lo);
            dbase = const_cast<float*>(out) + kv_group_base(g) + ((ci & 1) ? (size_t)40 * Wb * 512 : (size_t)4 * Wb * 512);
        }
    }
    __device__ __forceinline__ void decode_next(LAS unsigned char* lds) {
        const int g = ci >> 1, bb = g == 0 ? c / 31 : (g == 1 ? c / 127 : c / 511);
        cur_src = sbase + (size_t)(c + bb + 1) * 2048; cur_dst = dbase + (size_t)(c + bb) * 2048;
        c += step; if (c >= ncache) { c -= ncache; ++ci; setup(lds); }
    }
    __device__ __forceinline__ void load(LAS unsigned char* lds, int tid, unsigned ldsw) {
        inflight = ci < 6;
        if (inflight) { decode_next(lds);
            __builtin_amdgcn_global_load_lds((const unsigned*)(cur_src + tid * 4), (LAS unsigned*)(lds + CS_LDS_OFF + ldsw), 16, 0, 2  ); }
    }
    __device__ __forceinline__ void store(LAS unsigned char* lds, int tid) {
        if (inflight) { const f32x4 v = *(const LAS f32x4*)(lds + CS_LDS_OFF + tid * 16); __builtin_nontemporal_store(v, (f32x4*)(cur_dst + tid * 4)); }
    }
};
struct NoStream {
    __device__ __forceinline__ void load(LAS unsigned char*, int, unsigned) {}
    __device__ __forceinline__ void store(LAS unsigned char*, int) {}
};

namespace pg8 {
constexpr int BM = 256, BK = 64, HALF = 128, HTB = HALF * BK * 2, STAGE_BYTES = 8 * HTB, NXCD = 8, WGM = 8;
__host__ __device__ __forceinline__ int lds_byte(int r, int c) { const int st = (r >> 4) * 2 + (c >> 5), rr = r & 15, cc = c & 31, ob = rr * 64 + cc * 2; return st * 1024 + (ob ^ (((ob >> 9) & 1) << 5)); }
__host__ __device__ __forceinline__ void stage_rc(int b, int& R, int& C) { const int st = b / 1024, sb = b % 1024, swz = sb ^ (((sb >> 9) & 1) << 5); R = (st >> 1) * 16 + swz / 64; C = (st & 1) * 32 + (swz % 64) / 2; }
struct Unit { int pm, pn; };
struct Gemm { const bf16_t* A; const bf16_t* Bt; int M, N, K; };
struct StaticOrder {
    int nM, nN, nwg, G, c;
    __host__ __device__ void init(int M, int N, int G_, int c_) { nM = M / BM; nN = N / BM; nwg = nM * nN; G = G_; c = c_; }
    __host__ __device__ bool next(int i, Unit& u) const {
        const long L = (long)i * G + c; if (L >= nwg) return false;
        int wgid = (int)L; { const int q = nwg / NXCD, r = nwg % NXCD, xcd = wgid % NXCD, off = wgid / NXCD; wgid = (xcd < r ? xcd * (q + 1) : r * (q + 1) + (xcd - r) * q) + off; }
        const int nig = WGM * nN, gid = wgid / nig, fm = gid * WGM, gsz = (nM - fm) < WGM ? (nM - fm) : WGM;
        u.pm = fm + ((wgid % nig) % gsz); u.pn = (wgid % nig) / gsz; return true;
    }
};
template <class Epi, class Cp>
__device__ __forceinline__ void gemm_phase(LAS unsigned char* lds, const Gemm g, const StaticOrder& S, const Epi& E, Cp& cp) {
    const int tid = threadIdx.x, wid = __builtin_amdgcn_readfirstlane(tid >> 6), lane = tid & 63, wr = wid >> 2, wc = wid & 3, fr = lane & 15, fq = lane >> 4;
    const int K = g.K, nt = K / BK;
    unsigned voffA[2];
#pragma unroll
    for (int i = 0; i < 2; ++i) { int R, C; stage_rc(tid * 16 + i * 8192, R, C); voffA[i] = (unsigned)(R * K + C) * 2u; }
    const size_t kstep = (size_t)(BK * 2);
    const size_t hstep = (size_t)HALF * K * 2;
    const size_t tstep = 2 * hstep;
    const unsigned ldsw = (unsigned)wid * 1024u;
    const int aoff = lds_byte(wr * 64 + fr, fq * 8), boff = lds_byte(wc * 32 + fr, fq * 8);
#define PG8_SA(b, h) (((b) * 2 + (h)) * HTB)
#define PG8_SB(b, h) ((4 + (b) * 2 + (h)) * HTB)
#define PG8_STAGE(bufoff, gbase, voff) do { _Pragma("unroll") for (int _i = 0; _i < 2; ++_i) \
        __builtin_amdgcn_global_load_lds((const unsigned*)((const char*)(gbase) + (voff)[_i]), (LAS unsigned*)(lds + (bufoff) + ldsw + _i * 8192), 16, 0, 0); } while (0)
#define PG8_LDA(dst, b, h) do { _Pragma("unroll") for (int m = 0; m < 4; ++m) _Pragma("unroll") for (int k = 0; k < 2; ++k) dst[m][k] = *(const LAS bf16x8*)(lds + PG8_SA(b, h) + aoff + m * 2048 + k * 1024); } while (0)
#define PG8_LDB(dst, b, h) do { _Pragma("unroll") for (int n = 0; n < 2; ++n) _Pragma("unroll") for (int k = 0; k < 2; ++k) dst[n][k] = *(const LAS bf16x8*)(lds + PG8_SB(b, h) + boff + n * 2048 + k * 1024); } while (0)
#define PG8_MMA(ai, bj, At, Bt) do { __builtin_amdgcn_s_setprio(1); _Pragma("unroll") for (int m = 0; m < 4; ++m) _Pragma("unroll") for (int n = 0; n < 2; ++n) _Pragma("unroll") for (int k = 0; k < 2; ++k) \
        acc[ai][bj][m][n] = __builtin_amdgcn_mfma_f32_16x16x32_bf16(Bt[n][k], At[m][k], acc[ai][bj][m][n], 0, 0, 0); __builtin_amdgcn_s_setprio(0); } while (0)
#define PG8_WAIT_V(n) asm volatile("s_waitcnt vmcnt(" #n ")" ::: "memory")
#define PG8_WAIT_L(n) asm volatile("s_waitcnt lgkmcnt(" #n ")" ::: "memory")
#define PG8_BAR __builtin_amdgcn_s_barrier()
#define PG8_SCHED __builtin_amdgcn_sched_barrier(0)
    Unit cur, nxt; int ui = 0;
    if (!S.next(0, cur)) return;
    f32x4 acc[2][2][4][2];
#pragma unroll
    for (int a = 0; a < 2; ++a)
#pragma unroll
        for (int b = 0; b < 2; ++b)
#pragma unroll
            for (int m = 0; m < 4; ++m)
#pragma unroll
                for (int n = 0; n < 2; ++n) acc[a][b][m][n] = (f32x4){0.f, 0.f, 0.f, 0.f};
    bf16x8 At[4][2], B0[2][2], B1[2][2];
    const char* cA = (const char*)g.A + (size_t)cur.pm * tstep; const char* cB = (const char*)g.Bt + (size_t)cur.pn * tstep;
    PG8_STAGE(PG8_SB(0, 0), cB, voffA); PG8_STAGE(PG8_SA(0, 0), cA, voffA); PG8_STAGE(PG8_SB(0, 1), cB + hstep, voffA); PG8_STAGE(PG8_SA(0, 1), cA + hstep, voffA);
    if (wr == 1) PG8_BAR;
    PG8_WAIT_V(4); PG8_BAR;
    PG8_STAGE(PG8_SB(1, 0), cB + kstep, voffA); PG8_STAGE(PG8_SA(1, 0), cA + kstep, voffA); PG8_STAGE(PG8_SB(1, 1), cB + hstep + kstep, voffA);
    PG8_WAIT_V(6); PG8_BAR;
    for (;;) {
        const bool has_next = S.next(ui + 1, nxt);
        const char* nA = has_next ? (const char*)g.A + (size_t)nxt.pm * tstep : cA; const char* nB = has_next ? (const char*)g.Bt + (size_t)nxt.pn * tstep : cB;
        for (int t = 0; t < nt; t += 2) {
            const bool last = (t == nt - 2);
            const char* a1 = cA + (size_t)(t + 1) * kstep;
            const char* a2 = last ? nA : cA + (size_t)(t + 2) * kstep; const char* b2 = last ? nB : cB + (size_t)(t + 2) * kstep;
            const char* a3 = a2 + kstep; const char* b3 = b2 + kstep;
            PG8_LDB(B0, 0, 0); PG8_SCHED; PG8_LDA(At, 0, 0); PG8_STAGE(PG8_SA(1, 1), a1 + hstep, voffA);
            PG8_WAIT_L(8); PG8_BAR; PG8_WAIT_L(0); PG8_MMA(0, 0, At, B0); PG8_BAR; PG8_SCHED;
            PG8_LDB(B1, 0, 1); PG8_STAGE(PG8_SB(0, 0), b2, voffA);
            PG8_BAR; PG8_WAIT_L(0); PG8_MMA(0, 1, At, B1); PG8_BAR;
            PG8_LDA(At, 0, 1); PG8_STAGE(PG8_SA(0, 0), a2, voffA);
            PG8_BAR; PG8_WAIT_L(0); PG8_MMA(1, 0, At, B0); PG8_BAR; PG8_SCHED;
            PG8_STAGE(PG8_SB(0, 1), b2 + hstep, voffA);
            PG8_WAIT_V(6); cp.load(lds, tid, ldsw); PG8_BAR; PG8_MMA(1, 1, At, B1); PG8_BAR;
            PG8_LDB(B0, 1, 0); PG8_SCHED; PG8_LDA(At, 1, 0); PG8_STAGE(PG8_SA(0, 1), a2 + hstep, voffA);
            PG8_WAIT_L(8); PG8_BAR; PG8_WAIT_L(0); PG8_MMA(0, 0, At, B0); PG8_BAR; PG8_SCHED;
            PG8_LDB(B1, 1, 1); PG8_STAGE(PG8_SB(1, 0), b3, voffA);
            PG8_BAR; PG8_WAIT_L(0); PG8_MMA(0, 1, At, B1); PG8_BAR;
            PG8_LDA(At, 1, 1); PG8_STAGE(PG8_SA(1, 0), a3, voffA);
            PG8_BAR; PG8_WAIT_L(0); PG8_MMA(1, 0, At, B0); PG8_BAR; PG8_SCHED;
            PG8_STAGE(PG8_SB(1, 1), b3 + hstep, voffA);
            PG8_WAIT_V(6); PG8_BAR; PG8_MMA(1, 1, At, B1); cp.store(lds, tid); PG8_BAR;
        }
        E(acc, cur, wr, wc, fr, fq);
        if (!has_next) break;
#pragma unroll
        for (int a = 0; a < 2; ++a)
#pragma unroll
            for (int b = 0; b < 2; ++b)
#pragma unroll
                for (int m = 0; m < 4; ++m)
#pragma unroll
                    for (int n = 0; n < 2; ++n) acc[a][b][m][n] = (f32x4){0.f, 0.f, 0.f, 0.f};
        cur = nxt; cA = nA; cB = nB; ++ui;
    }
    PG8_WAIT_V(0);
    if (wr == 0) PG8_BAR;
    PG8_BAR;
#undef PG8_SA
#undef PG8_SB
#undef PG8_STAGE
#undef PG8_LDA
#undef PG8_LDB
#undef PG8_MMA
#undef PG8_WAIT_V
#undef PG8_WAIT_L
#undef PG8_BAR
#undef PG8_SCHED
}
}
using pg8::Unit;

struct RowInfo { int b, t, pidx; bool prompt; };
__device__ __forceinline__ RowInfo row_info(int row) { RowInfo r; r.prompt = row < NPR; if (r.prompt) { r.b = row >> 11; r.t = row & 2047; r.pidx = r.t; } else { const int s = row - NPR; r.b = s >> 2; r.t = s & 3; r.pidx = 2048 + r.t; } return r; }

struct EpiIn {
    bf16_t *U, *Q, *K, *V, *GC, *GA; float* out; const float* bglu; const float* rope;
    __device__ __forceinline__ void kv_out(bool isK, const RowInfo& ri, int head, int dim, const f32x4& v0, const f32x4& v1, bool split16) const {
        const int g = head >> 2, hs = head & 3, win = 128 << (2 * g);
        const size_t gb = kv_group_base(g);
        size_t off;
        if (ri.prompt) { if (ri.t < 2048 - win) return; off = gb + (isK ? 0 : (size_t)36 * win * 512) + ((size_t)(ri.b * win + (ri.t - (2048 - win))) * 4 + hs) * 128 + dim; }
        else off = gb + (isK ? (size_t)4 * win * 512 : (size_t)40 * win * 512) + ((size_t)(ri.b * win + win - 4 + ri.t) * 4 + hs) * 128 + dim;
        *(f32x4*)(out + off) = v0; *(f32x4*)(out + off + (split16 ? 16 : 4)) = v1;
    }
    __device__ __forceinline__ void row(int row, int pn, int wc, int fq, const f32x4 (&v)[2][2]) const {
        if (row >= MR) return;
        const RowInfo ri = row_info(row);
        if (pn < 8) {
            const int c0 = pn * 128 + wc * 32 + fq * 8;
            f32x4 uu[2];
#pragma unroll
            for (int n = 0; n < 2; ++n) {
                const f32x4 ba = *(const f32x4*)(bglu + c0 + 4 * n), bb = *(const f32x4*)(bglu + 1024 + c0 + 4 * n);
#pragma unroll
                for (int j = 0; j < 4; ++j) uu[n][j] = (v[0][n][j] + ba[j]) * sigmoidf_(v[1][n][j] + bb[j]);
            }
            *(u32x4*)(U + (size_t)row * DC + c0) = pack8(uu[0], uu[1]);
            if (ri.prompt) { if (ri.t >= 2018) { float* o = out + OFF_CONVP + ((size_t)(ri.b * 30 + ri.t - 2018)) * 1024 + c0; *(f32x4*)o = uu[0]; *(f32x4*)(o + 4) = uu[1]; } }
            else { float* o = out + OFF_CONVS + ((size_t)(ri.b * 30 + 26 + ri.t)) * 1024 + c0; *(f32x4*)o = uu[0]; *(f32x4*)(o + 4) = uu[1]; }
        } else if (pn < 20) {
            const bool isK = pn >= 14; bf16_t* buf = isK ? K : Q; const int hp = (isK ? pn - 14 : pn - 8) * 2;
#pragma unroll
            for (int bj = 0; bj < 2; ++bj) {
                const int head = hp + bj; bf16_t* dst = buf + (size_t)row * AW + head * 128;
                if (wc == 0) {
                    const f32x4 x1 = v[bj][0], x2 = v[bj][1];
                    const float* rp = rope + ((size_t)ri.pidx * 16 + 4 * fq) * 2;
                    const f32x4 cs0 = *(const f32x4*)rp, cs1 = *(const f32x4*)(rp + 4);
                    f32x4 o1, o2;
                    o1[0] = x1[0] * cs0[0] - x2[0] * cs0[1]; o2[0] = x2[0] * cs0[0] + x1[0] * cs0[1];
                    o1[1] = x1[1] * cs0[2] - x2[1] * cs0[3]; o2[1] = x2[1] * cs0[2] + x1[1] * cs0[3];
                    o1[2] = x1[2] * cs1[0] - x2[2] * cs1[1]; o2[2] = x2[2] * cs1[0] + x1[2] * cs1[1];
                    o1[3] = x1[3] * cs1[2] - x2[3] * cs1[3]; o2[3] = x2[3] * cs1[2] + x1[3] * cs1[3];
                    u32x2 w1, w2; w1.x = cvt_pk_bf16(o1[0], o1[1]); w1.y = cvt_pk_bf16(o1[2], o1[3]); w2.x = cvt_pk_bf16(o2[0], o2[1]); w2.y = cvt_pk_bf16(o2[2], o2[3]);
                    *(u32x2*)(dst + 4 * fq) = w1; *(u32x2*)(dst + 16 + 4 * fq) = w2;
                    if (isK) kv_out(true, ri, head, 4 * fq, o1, o2, true);
                } else {
                    const int d0 = wc * 32 + fq * 8;
                    *(u32x4*)(dst + d0) = pack8(v[bj][0], v[bj][1]);
                    if (isK) kv_out(true, ri, head, d0, v[bj][0], v[bj][1], false);
                }
            }
        } else if (pn < 26) {
            const int hp = (pn - 20) * 2, d0 = wc * 32 + fq * 8;
#pragma unroll
            for (int bj = 0; bj < 2; ++bj) {
                const int head = hp + bj;
                *(u32x4*)(V + (size_t)row * AW + head * 128 + d0) = pack8(v[bj][0], v[bj][1]);
                kv_out(false, ri, head, d0, v[bj][0], v[bj][1], false);
            }
        } else {
            bf16_t* buf = pn < 34 ? GC : GA; const int cb = (pn < 34 ? pn - 26 : pn - 34) * 256 + wc * 32 + fq * 8;
#pragma unroll
            for (int bj = 0; bj < 2; ++bj) {
                f32x4 g0, g1;
#pragma unroll
                for (int j = 0; j < 4; ++j) { g0[j] = sigmoidf_(v[bj][0][j]); g1[j] = sigmoidf_(v[bj][1][j]); }
                *(u32x4*)(buf + (size_t)row * DM + cb + bj * 128) = pack8(g0, g1);
            }
        }
    }
};
struct EpiPw {
    bf16_t* T1; const bf16_t* GC; const float* bpw;
    __device__ __forceinline__ void row(int row, int pn, int wc, int fq, const f32x4 (&v)[2][2]) const {
        if (row >= MR) return;
#pragma unroll
        for (int bj = 0; bj < 2; ++bj) {
            const int c0 = pn * 256 + bj * 128 + wc * 32 + fq * 8;
            const f32x4 b0 = *(const f32x4*)(bpw + c0), b1 = *(const f32x4*)(bpw + c0 + 4);
            f32x4 g0, g1; unpack8(*(const u32x4*)(GC + (size_t)row * DM + c0), g0, g1);
            *(u32x4*)(T1 + (size_t)row * DM + c0) = pack8((v[bj][0] + b0) * g0, (v[bj][1] + b1) * g1);
        }
    }
};
struct EpiOa {
    const bf16_t* T1; const bf16_t* GA; bf16_t* MIX;
    __device__ __forceinline__ void row(int row, int pn, int wc, int fq, const f32x4 (&v)[2][2]) const {
        if (row >= MR) return;
#pragma unroll
        for (int bj = 0; bj < 2; ++bj) {
            const int c0 = pn * 256 + bj * 128 + wc * 32 + fq * 8;
            f32x4 g0, g1; unpack8(*(const u32x4*)(GA + (size_t)row * DM + c0), g0, g1);
            f32x4 t0, t1; unpack8(*(const u32x4*)(T1 + (size_t)row * DM + c0), t0, t1);
            *(u32x4*)(MIX + (size_t)row * DM + c0) = pack8(t0 + v[bj][0] * g0, t1 + v[bj][1] * g1);
        }
    }
};
struct EpiRes {
    const float* xp; const float* xs; size_t xs_row0;
    float* XO; bf16_t* XB; float* SS; const bf16_t* SB;
    __device__ __forceinline__ void row(int row, int pn, int wc, int fq, const f32x4 (&v)[2][2]) const {
        const bool ok = row < MR;
        float ss = 0.f;
        if (ok) {
            const float* src = row < NPR ? xp + (size_t)row * DM : xs + ((size_t)row - xs_row0) * DM;
#pragma unroll
            for (int bj = 0; bj < 2; ++bj) {
                const int c0 = pn * 256 + bj * 128 + wc * 32 + fq * 8;
                f32x4 r0, r1;
                if (SB) unpack8(*(const u32x4*)(SB + (size_t)row * DM + c0), r0, r1); else { r0 = *(const f32x4*)(src + c0); r1 = *(const f32x4*)(src + c0 + 4); }
                const f32x4 v0 = r0 + v[bj][0], v1 = r1 + v[bj][1];
                if (XO) { float* o = XO + (size_t)row * DM + c0; *(f32x4*)o = v0; *(f32x4*)(o + 4) = v1; }
                if (XB) *(u32x4*)(XB + (size_t)row * DM + c0) = pack8(v0, v1);
                ss += v0[0] * v0[0] + v0[1] * v0[1] + v0[2] * v0[2] + v0[3] * v0[3] + v1[0] * v1[0] + v1[1] * v1[1] + v1[2] * v1[2] + v1[3] * v1[3];
            }
        }
        ss += __shfl_xor(ss, 16); ss += __shfl_xor(ss, 32);
        if (ok && fq == 0) atomicAdd(SS + row, ss);
    }
};
struct EpiGu {
    const float* SS; bf16_t* HID;
    __device__ __forceinline__ void row(int row, int pn, int wc, int fq, const f32x4 (&v)[2][2]) const {
        if (row >= MR) return;
        const int c0 = pn * 128 + wc * 32 + fq * 8;
        const float r = __builtin_amdgcn_rsqf(SS[row] * (1.0f / DM) + NORM_EPS);
        f32x4 h[2];
#pragma unroll
        for (int n = 0; n < 2; ++n)
#pragma unroll
            for (int j = 0; j < 4; ++j) { const float gt = v[0][n][j] * r, up = v[1][n][j] * r; h[n][j] = gt * sigmoidf_(gt) * up; }
        *(u32x4*)(HID + (size_t)row * FH + c0) = pack8(h[0], h[1]);
    }
};
constexpr int CW_FIN = 4096;
struct EpiFinalTile {
    const bf16_t* XB; float* out; float* SS; unsigned* cnt; const float* gfin;
    __device__ __forceinline__ void operator()(const f32x4 (&acc)[2][2][4][2], const Unit& u, int wr, int wc, int fr, int fq) const {
        const int rowb = u.pm * 256 + wr * 64 + fr;
#pragma unroll
        for (int ai = 0; ai < 2; ++ai)
#pragma unroll
            for (int m = 0; m < 4; ++m) {
                const int row = rowb + ai * 128 + m * 16; float ss = 0.f;
#pragma unroll
                for (int bj = 0; bj < 2; ++bj) {
                    const int c0 = u.pn * 256 + bj * 128 + wc * 32 + fq * 8;
                    f32x4 r0, r1; unpack8(*(const u32x4*)(XB + (size_t)row * DM + c0), r0, r1);
                    const f32x4 v0 = r0 + acc[ai][bj][m][0], v1 = r1 + acc[ai][bj][m][1];
                    ss += v0[0] * v0[0] + v0[1] * v0[1] + v0[2] * v0[2] + v0[3] * v0[3] + v1[0] * v1[0] + v1[1] * v1[1] + v1[2] * v1[2] + v1[3] * v1[3];
                }
                ss += __shfl_xor(ss, 16); ss += __shfl_xor(ss, 32);
                if (fq == 0) atomicAdd(SS + row, ss);
            }
        asm volatile("s_waitcnt vmcnt(0)" ::: "memory");
        unsigned* c = cnt + CW_FIN + 64 * (2 * u.pm + wr);
        if ((threadIdx.x & 63) == 0) {
            (void)__hip_atomic_fetch_add(c, 1u, __ATOMIC_RELAXED, __HIP_MEMORY_SCOPE_AGENT);
            unsigned sp = 0;
            while (__hip_atomic_load(c, __ATOMIC_RELAXED, __HIP_MEMORY_SCOPE_AGENT) < 32u) { __builtin_amdgcn_s_sleep(1); if (++sp > (1u << 17)) break; }
        }
        asm volatile("" ::: "memory");
#pragma unroll
        for (int ai = 0; ai < 2; ++ai)
#pragma unroll
            for (int m = 0; m < 4; ++m) {
                const int row = rowb + ai * 128 + m * 16;
                const float r = __builtin_amdgcn_rsqf(__hip_atomic_load(SS + row, __ATOMIC_RELAXED, __HIP_MEMORY_SCOPE_AGENT) * (1.0f / DM) + NORM_EPS);
#pragma unroll
                for (int bj = 0; bj < 2; ++bj) {
                    const int c0 = u.pn * 256 + bj * 128 + wc * 32 + fq * 8;
                    f32x4 r0, r1; unpack8(*(const u32x4*)(XB + (size_t)row * DM + c0), r0, r1);
                    const f32x4 g0 = *(const f32x4*)(gfin + c0), g1 = *(const f32x4*)(gfin + c0 + 4);
                    float* o = out + (size_t)row * DM + c0;
                    *(f32x4*)o = (r0 + acc[ai][bj][m][0]) * r * g0; *(f32x4*)(o + 4) = (r1 + acc[ai][bj][m][1]) * r * g1;
                }
            }
    }
};

struct EpiFinalRow {
    const bf16_t* XB; float* out; float* SS; unsigned* cnt; const float* gfin;
    __device__ __forceinline__ void row(int row, int pn, int wc, int fq, const f32x4 (&v)[2][2]) const {
        f32x4 x0[2], x1[2]; float ss = 0.f;
#pragma unroll
        for (int bj = 0; bj < 2; ++bj) {
            const int c0 = pn * 256 + bj * 128 + wc * 32 + fq * 8;
            f32x4 r0, r1; unpack8(*(const u32x4*)(XB + (size_t)row * DM + c0), r0, r1);
            x0[bj] = r0 + v[bj][0]; x1[bj] = r1 + v[bj][1];
            ss += x0[bj][0] * x0[bj][0] + x0[bj][1] * x0[bj][1] + x0[bj][2] * x0[bj][2] + x0[bj][3] * x0[bj][3] + x1[bj][0] * x1[bj][0] + x1[bj][1] * x1[bj][1] + x1[bj][2] * x1[bj][2] + x1[bj][3] * x1[bj][3];
        }
        ss += __shfl_xor(ss, 16); ss += __shfl_xor(ss, 32);
        if (fq == 0) atomicAdd(SS + row, ss);
        asm volatile("s_waitcnt vmcnt(0)" ::: "memory");
        unsigned* c = cnt + CW_FIN + 64 * (64 + ((row - NPR) >> 4));
        if ((threadIdx.x & 63) == 0) {
            (void)__hip_atomic_fetch_add(c, 1u, __ATOMIC_RELAXED, __HIP_MEMORY_SCOPE_AGENT);
            unsigned sp = 0;
            while (__hip_atomic_load(c, __ATOMIC_RELAXED, __HIP_MEMORY_SCOPE_AGENT) < 32u) { __builtin_amdgcn_s_sleep(1); if (++sp > (1u << 17)) break; }
        }
        asm volatile("" ::: "memory");
        const float r = __builtin_amdgcn_rsqf(__hip_atomic_load(SS + row, __ATOMIC_RELAXED, __HIP_MEMORY_SCOPE_AGENT) * (1.0f / DM) + NORM_EPS);
#pragma unroll
        for (int bj = 0; bj < 2; ++bj) {
            const int c0 = pn * 256 + bj * 128 + wc * 32 + fq * 8;
            const f32x4 g0 = *(const f32x4*)(gfin + c0), g1 = *(const f32x4*)(gfin + c0 + 4);
            float* o = out + (size_t)row * DM + c0;
            *(f32x4*)o = x0[bj] * r * g0; *(f32x4*)(o + 4) = x1[bj] * r * g1;
        }
    }
};

template <class Epi> struct TileEpi {
    Epi e;
    __device__ __forceinline__ void operator()(const f32x4 (&acc)[2][2][4][2], const Unit& u, int wr, int wc, int fr, int fq) const {
#pragma unroll
        for (int ai = 0; ai < 2; ++ai)
#pragma unroll
            for (int m = 0; m < 4; ++m) {
                const f32x4 v[2][2] = {{acc[ai][0][m][0], acc[ai][0][m][1]}, {acc[ai][1][m][0], acc[ai][1][m][1]}};
                e.row(u.pm * 256 + ai * 128 + wr * 64 + m * 16 + fr, u.pn, wc, fq, v);
            }
    }
};

template <class Epi>
__device__ __forceinline__ void skinny_phase(LAS unsigned char* lds, const bf16_t* A, const bf16_t* Bt, int K, int N, const Epi& E, int first_block) {
    const int bid = blockIdx.x, G = gridDim.x;
    if (bid < first_block) return;
    const int tid = threadIdx.x, w = tid >> 6, lane = tid & 63, fr = lane & 15, fq = lane >> 4, nb = G - first_block, nsu = (N / 64) * 8;
    const int nks = K / 256;
    for (int su = bid - first_block; su < nsu; su += nb) {
        const int rt = su & 7, pw = su >> 3, pn = pw >> 2, wc = pw & 3;
        const bf16_t* ap = A + (size_t)(NPR + 16 * rt + fr) * K + 8 * fq + w * nks * 32;
        const bf16_t* bp = Bt + (size_t)(pn * 256 + wc * 32 + fr) * K + 8 * fq + w * nks * 32;
        f32x4 acc[4];
#pragma unroll
        for (int i = 0; i < 4; ++i) acc[i] = (f32x4){0.f, 0.f, 0.f, 0.f};
        for (int ks = 0; ks < nks; ks += 2) {
            bf16x8 af[2], bf[2][4];
#pragma unroll
            for (int k2 = 0; k2 < 2; ++k2) {
                af[k2] = *(const bf16x8*)(ap + (ks + k2) * 32);
#pragma unroll
                for (int i = 0; i < 4; ++i) bf[k2][i] = *(const bf16x8*)(bp + (size_t)((i >> 1) * 128 + (i & 1) * 16) * K + (ks + k2) * 32);
            }
#pragma unroll
            for (int k2 = 0; k2 < 2; ++k2)
#pragma unroll
                for (int i = 0; i < 4; ++i) acc[i] = __builtin_amdgcn_mfma_f32_16x16x32_bf16(bf[k2][i], af[k2], acc[i], 0, 0, 0);
        }
        __syncthreads();
#pragma unroll
        for (int i = 0; i < 4; ++i) *(LAS f32x4*)(lds + (w * 4 + i) * 1024 + lane * 16) = acc[i];
        __syncthreads();
        if (w == 0) {
#pragma unroll
            for (int ww = 1; ww < 8; ++ww)
#pragma unroll
                for (int i = 0; i < 4; ++i) acc[i] += *(const LAS f32x4*)(lds + (ww * 4 + i) * 1024 + lane * 16);
            const f32x4 v[2][2] = {{acc[0], acc[1]}, {acc[2], acc[3]}};
            E.row(NPR + 16 * rt + fr, pn, wc, fq, v);
        }
    }
}

template <int KIND>
__device__ __forceinline__ const float* wsrc4(const float* w0, const float* w1, int p) {
    const int rho = p & 31, pb = p & ~31;
    if (KIND == 0) return w0 + pb + perm32(rho);
    if (KIND == 2) { const int pn = p >> 8, bj = (p >> 7) & 1, w = p & 127; const int off = pn * 128 + (w & ~31) + perm32(rho); const float* r0 = w0 + off; const float* r1 = w1 + off; return bj ? r1 : r0; }
    const int pn = p >> 8, bj = (p >> 7) & 1, w = p & 127, wc = w >> 5;
    if (pn < 8) return w0 + bj * 1024 + pn * 128 + wc * 32 + perm32(rho);
    if (pn < 20) return w0 + pb + (wc == 0 ? rho : perm32(rho));
    return w0 + pb + perm32(rho);
}
template <int KIND>
__device__ __forceinline__ void wcopy_unit(LAS float* tile, const float* w0, const float* w1, int ldw, int K, const float* kscale, bf16_t* dst, int kt, int pt) {
    const int tid = threadIdx.x, k0 = kt * 64, p0 = pt * 256;
    const int kk = tid >> 4, c4 = tid & 15;
    f32x4 v[4][2];
#pragma unroll
    for (int sbt = 0; sbt < 4; ++sbt) {
        const float* src = wsrc4<KIND>(w0, w1, p0 + sbt * 64 + 4 * c4);
#pragma unroll
        for (int i = 0; i < 2; ++i) v[sbt][i] = __builtin_nontemporal_load((const f32x4*)(src + (size_t)(k0 + kk + 32 * i) * ldw));
    }
#pragma unroll
    for (int sbt = 0; sbt < 4; ++sbt)
#pragma unroll
        for (int i = 0; i < 2; ++i) {
            f32x4 x = v[sbt][i];
            if (KIND == 2) x = x * kscale[k0 + kk + 32 * i];
            LAS float* d = tile + sbt * (64 * 65) + (kk + 32 * i) * 65 + 4 * c4; d[0] = x[0]; d[1] = x[1]; d[2] = x[2]; d[3] = x[3];
        }
    __syncthreads();
    const int pp = tid >> 3, kc = tid & 7;
#pragma unroll
    for (int sbt = 0; sbt < 4; ++sbt) {
        f32x4 a, b;
#pragma unroll
        for (int j = 0; j < 4; ++j) { a[j] = tile[sbt * (64 * 65) + (kc * 8 + j) * 65 + pp]; b[j] = tile[sbt * (64 * 65) + (kc * 8 + 4 + j) * 65 + pp]; }
        *(u32x4*)(dst + (size_t)(p0 + sbt * 64 + pp) * K + k0 + kc * 8) = pack8(a, b);
    }
    __syncthreads();
}

__constant__ double ROPE_INV[16] = {1.0, 0.44036660267178046, 0.19392274474868576, 0.08539710028576561, 0.03760603093086393, 0.016560440080994446, 0.007292664737217109, 0.003211445994752591,
                                    0.001414213562373095, 0.000622772421914596, 0.0002742481756762073, 0.00012076973741146504, 5.318295896944988e-05, 2.341999896140934e-05, 1.031338537721246e-05, 4.5416704806078695e-06};

constexpr int KSTR = 272, VOFF_LDS = 256 * KSTR;
__device__ __forceinline__ void attn_prompt_unit(LAS unsigned char* lds, int unit, const bf16_t* Qb, const bf16_t* Kb, const bf16_t* Vb, bf16_t* OG, float* LSE) {
    const int tid = threadIdx.x, w = __builtin_amdgcn_readfirstlane(tid >> 6), lane = tid & 63, fr = lane & 15, fq = lane >> 4;
    const int g = unit >> 8, rem = unit & 255, b = rem >> 6, hs = (rem >> 4) & 3, rb = rem & 15;
    const int sh = 2 * g, lnb = 4 - 2 * g, r = rb >> lnb, blk = rb & ((1 << lnb) - 1);
    const int head = 4 * g + hs;
    const size_t rowbase = (size_t)b * 2048 + r;
    __syncthreads();
#pragma unroll
    for (int it = 0; it < 8; ++it) {
        const int idx = tid + it * 512;
        const int key = idx >> 4, ch = idx & 15;
        int sp = (blk - 1) * 128 + key; if (sp < 0) sp += 128;
        const size_t off = (rowbase + ((size_t)sp << sh)) * AW + head * 128 + ch * 8;
        const u32x4 kv = *(const u32x4*)(Kb + off), vv = *(const u32x4*)(Vb + off);
        *(LAS u32x4*)(lds + key * KSTR + ch * 16) = kv;
        *(LAS u32x4*)(lds + VOFF_LDS + key * KSTR + ch * 16) = vv;
    }
    const int qi = 16 * w + fr;
    const size_t rowq = rowbase + ((size_t)(blk * 128 + qi) << sh);
    bf16x8 qf[4];
#pragma unroll
    for (int ks = 0; ks < 4; ++ks) qf[ks] = *(const bf16x8*)(Qb + rowq * AW + head * 128 + ks * 32 + fq * 8);
    __syncthreads();
    f32x4 sacc[10];
#pragma unroll
    for (int kt = 0; kt < 10; ++kt) {
        sacc[kt] = (f32x4){0.f, 0.f, 0.f, 0.f};
        const int tile = (w + kt) < 15 ? (w + kt) : 15;
#pragma unroll
        for (int ks = 0; ks < 4; ++ks) {
            const bf16x8 kf = *(const LAS bf16x8*)(lds + (tile * 16 + fr) * KSTR + (ks * 32 + fq * 8) * 2);
            sacc[kt] = __builtin_amdgcn_mfma_f32_16x16x32_bf16(kf, qf[ks], sacc[kt], 0, 0, 0);
        }
    }
    float mx = -INFINITY;
#pragma unroll
    for (int kt = 0; kt < 10; ++kt)
#pragma unroll
        for (int j = 0; j < 4; ++j) {
            const int ki = 16 * (w + kt) + 4 * fq + j, dist = 128 + qi - ki;
            const bool valid = (dist >= 0) && (dist <= 128) && (blk > 0 || ki >= 128);
            const float s = valid ? sacc[kt][j] * ATT_SCALE_LOG2E : -INFINITY;
            sacc[kt][j] = s; mx = fmaxf(mx, s);
        }
    mx = fmaxf(mx, __shfl_xor(mx, 16)); mx = fmaxf(mx, __shfl_xor(mx, 32));
    float den = 0.f;
#pragma unroll
    for (int kt = 0; kt < 10; ++kt)
#pragma unroll
        for (int j = 0; j < 4; ++j) { const float p = __builtin_amdgcn_exp2f(sacc[kt][j] - mx); sacc[kt][j] = p; den += p; }
    den += __shfl_xor(den, 16); den += __shfl_xor(den, 32);
    f32x4 oacc[8];
#pragma unroll
    for (int c = 0; c < 8; ++c) oacc[c] = (f32x4){0.f, 0.f, 0.f, 0.f};
    const int q4 = fr >> 2, p4 = fr & 3;
#pragma unroll
    for (int s = 0; s < 5; ++s) {
        bf16x8 pf; u32x4 pw; pw.x = cvt_pk_bf16(sacc[2 * s][0], sacc[2 * s][1]); pw.y = cvt_pk_bf16(sacc[2 * s][2], sacc[2 * s][3]);
        pw.z = cvt_pk_bf16(sacc[2 * s + 1][0], sacc[2 * s + 1][1]); pw.w = cvt_pk_bf16(sacc[2 * s + 1][2], sacc[2 * s + 1][3]);
        pf = __builtin_bit_cast(bf16x8, pw);
        const int t0 = (w + 2 * s) < 15 ? (w + 2 * s) : 15, t1 = (w + 2 * s + 1) < 15 ? (w + 2 * s + 1) : 15;
        const unsigned a0 = VOFF_LDS + (t0 * 16 + 4 * fq + q4) * KSTR + p4 * 8, a1 = VOFF_LDS + (t1 * 16 + 4 * fq + q4) * KSTR + p4 * 8;
#pragma unroll
        for (int c = 0; c < 8; ++c) {
            const s16x4 v0 = __builtin_amdgcn_ds_read_tr16_b64_v4i16((LAS s16x4*)(lds + a0 + c * 32));
            const s16x4 v1 = __builtin_amdgcn_ds_read_tr16_b64_v4i16((LAS s16x4*)(lds + a1 + c * 32));
            bf16x8 vf; vf[0] = v0[0]; vf[1] = v0[1]; vf[2] = v0[2]; vf[3] = v0[3]; vf[4] = v1[0]; vf[5] = v1[1]; vf[6] = v1[2]; vf[7] = v1[3];
            oacc[c] = __builtin_amdgcn_mfma_f32_16x16x32_bf16(vf, pf, oacc[c], 0, 0, 0);
        }
    }
    const float inv = 1.0f / den;
    bf16_t* dst = OG + ((size_t)g * MP + rowq) * AO + hs * 128 + 4 * fq;
#pragma unroll
    for (int c = 0; c < 8; ++c) { u32x2 wv; wv.x = cvt_pk_bf16(oacc[c][0] * inv, oacc[c][1] * inv); wv.y = cvt_pk_bf16(oacc[c][2] * inv, oacc[c][3] * inv); *(u32x2*)(dst + c * 16) = wv; }
    if (fq == 0) LSE[((size_t)g * MP + rowq) * 4 + hs] = (mx + __builtin_amdgcn_logf(den)) * LN2F;
}

__device__ __forceinline__ void attn_sample_unit(int unit, const Args& a, const bf16_t* Qb, bf16_t* OG, float* LSE) {
    const int tid = threadIdx.x, w = tid >> 6, lane = tid & 63, sub = lane & 15, kq = lane >> 4;
    const int idx = unit * 8 + w, b = idx / 48, rem = idx % 48, t = rem / 12, head = rem % 12, g = head >> 2, hs = head & 3, dil = 1 << (2 * g), Wb = 128 * dil;
    const float* ck = g == 0 ? a.in[3] : (g == 1 ? a.in[5] : a.in[7]); const float* cv = g == 0 ? a.in[4] : (g == 1 ? a.in[6] : a.in[8]);
    const float* ok = a.out + kv_group_base(g) + (size_t)4 * Wb * 512; const float* ov = a.out + kv_group_base(g) + (size_t)40 * Wb * 512;
    const size_t row = (size_t)NPR + b * 4 + t, bbase = (size_t)b * Wb * 512 + hs * 128 + 8 * sub;
    f32x4 q0, q1; unpack8(*(const u32x4*)(Qb + row * AW + head * 128 + 8 * sub), q0, q1);
    float m = -INFINITY, l = 0.f; f32x4 o0 = (f32x4){0.f, 0.f, 0.f, 0.f}, o1 = o0;
#pragma unroll 3
    for (int i = 0; i < 33; ++i) {
        const int j = 4 * i + kq; const bool valid = j <= 128;
        const int ci = Wb + t - (valid ? j : 128) * dil;
        const bool fresh = ci >= Wb;
        const float* kp = (fresh ? ok + (size_t)(ci - 4) * 512 : ck + (size_t)ci * 512) + bbase;
        const float* vp = (fresh ? ov + (size_t)(ci - 4) * 512 : cv + (size_t)ci * 512) + bbase;
        const f32x4 k0 = *(const f32x4*)kp, k1 = *(const f32x4*)(kp + 4), v0 = *(const f32x4*)vp, v1 = *(const f32x4*)(vp + 4);
        float s = q0[0] * k0[0] + q0[1] * k0[1] + q0[2] * k0[2] + q0[3] * k0[3] + q1[0] * k1[0] + q1[1] * k1[1] + q1[2] * k1[2] + q1[3] * k1[3];
        s += __shfl_xor(s, 1); s += __shfl_xor(s, 2); s += __shfl_xor(s, 4); s += __shfl_xor(s, 8);
        s = valid ? s * ATT_SCALE_LOG2E : -INFINITY;
        const float mn = fmaxf(m, s), sc = __builtin_amdgcn_exp2f(m - mn), p = __builtin_amdgcn_exp2f(s - mn);
        l = l * sc + p; o0 = o0 * sc + v0 * p; o1 = o1 * sc + v1 * p; m = mn;
    }
#pragma unroll
    for (int x = 16; x <= 32; x <<= 1) {
        const float m2 = __shfl_xor(m, x), l2 = __shfl_xor(l, x);
        f32x4 p0, p1;
#pragma unroll
        for (int e = 0; e < 4; ++e) { p0[e] = __shfl_xor(o0[e], x); p1[e] = __shfl_xor(o1[e], x); }
        const float mn = fmaxf(m, m2), s1 = __builtin_amdgcn_exp2f(m - mn), s2 = __builtin_amdgcn_exp2f(m2 - mn);
        l = l * s1 + l2 * s2; o0 = o0 * s1 + p0 * s2; o1 = o1 * s1 + p1 * s2; m = mn;
    }
    if (kq == 0) {
        const float inv = 1.0f / l;
        *(u32x4*)(OG + ((size_t)g * MP + row) * AO + hs * 128 + 8 * sub) = pack8(o0 * inv, o1 * inv);
        if (sub == 0) LSE[((size_t)g * MP + row) * 4 + hs] = (m + __builtin_amdgcn_logf(l)) * LN2F;
    }
}

__device__ __forceinline__ void conv_unit(LAS unsigned char* lds, int unit, const Args& a, const bf16_t* U, bf16_t* CACT, const f32x2 (&wd)[31], const f32x2 bdw, const f32x2 lng, const f32x2 lnb) {
    const int tid = threadIdx.x, wid = tid >> 6, lane = tid & 63;
    const bool prompt = unit < 512;
    const int b = prompt ? unit >> 7 : unit - 512, t0 = prompt ? (unit & 127) * 16 : 0, ntok = prompt ? 16 : 4, nrows = ntok + 30;
    const size_t row0 = prompt ? (size_t)b * 2048 + t0 : (size_t)NPR + b * 4;
    __syncthreads();
    if (prompt) {
#pragma unroll
        for (int it = 0; it < 12; ++it) {
            const int idx = tid + it * 512, rr = idx >> 7, ch = idx & 127, tt = t0 - 30 + rr;
            if (it < 11 || idx < 46 * 128) {
                u32x4 v = *(const u32x4*)(U + ((size_t)b * 2048 + (tt < 0 ? 0 : tt)) * DC + ch * 8);
                if (tt < 0) v = (u32x4){0u, 0u, 0u, 0u};
                *(LAS u32x4*)(lds + rr * 2048 + ch * 16) = v;
            }
        }
    } else {
        for (int idx = tid; idx < nrows * 128; idx += 512) {
            const int rr = idx >> 7, ch = idx & 127;
            u32x4 v;
            if (rr < 30) { const float* sp_ = a.in[2] + ((size_t)b * 30 + rr) * 1024 + ch * 8; v = pack8(*(const f32x4*)sp_, *(const f32x4*)(sp_ + 4)); }
            else v = *(const u32x4*)(U + (row0 + rr - 30) * DC + ch * 8);
            *(LAS u32x4*)(lds + rr * 2048 + ch * 16) = v;
        }
    }
    __syncthreads();
    f32x2 y[16];
#pragma unroll
    for (int i = 0; i < 16; ++i) y[i] = bdw;
#pragma unroll
    for (int rr = 0; rr < 46; ++rr) {
        const unsigned xw = *(const LAS unsigned*)(lds + rr * 2048 + tid * 4);
        const f32x2 x = (f32x2){bf_lo(xw), bf_hi(xw)};
#pragma unroll
        for (int i = 0; i < 16; ++i) { const int j = rr - i; if (j >= 0 && j <= 30) y[i] += wd[j] * x; }
    }
    LAS float* red = (LAS float*)(lds + 96 * 1024);
#pragma unroll
    for (int i = 0; i < 16; ++i) {
        float s1 = y[i][0] + y[i][1], s2 = y[i][0] * y[i][0] + y[i][1] * y[i][1];
#pragma unroll
        for (int o = 1; o < 64; o <<= 1) { s1 += __shfl_xor(s1, o); s2 += __shfl_xor(s2, o); }
        if (lane == 0) { red[wid * 32 + 2 * i] = s1; red[wid * 32 + 2 * i + 1] = s2; }
    }
    __syncthreads();
    if (tid < 32) { float s = 0.f;
#pragma unroll
        for (int ww = 0; ww < 8; ++ww) s += red[ww * 32 + tid];
        red[256 + tid] = s; }
    __syncthreads();
#pragma unroll
    for (int i = 0; i < 16; ++i) {
        if (i < ntok) {
            const float mu = red[256 + 2 * i] * (1.0f / DC), var = red[256 + 2 * i + 1] * (1.0f / DC) - mu * mu, rs = __builtin_amdgcn_rsqf(var + LN_EPS);
            const float z0 = (y[i][0] - mu) * rs * lng[0] + lnb[0], z1 = (y[i][1] - mu) * rs * lng[1] + lnb[1];
            *(unsigned*)(CACT + (row0 + i) * DC + tid * 2) = cvt_pk_bf16(z0 * sigmoidf_(z0), z1 * sigmoidf_(z1));
        }
    }
}

#define XB_TMO      128
#define XB_XCNT(j)  (256  + 64 * (j))
#define XB_XSUB(j)  (1280 + 64 * (j))
#define XB_XGEN(j)  (2304 + 64 * (j))
#define XB_TOP      3328
#define XB_TOPGEN   3392
#define XCD_BAR_WORDS 3456
#define XB_SPIN_CAP (1u << 18)
__device__ __forceinline__ unsigned xb_ld(unsigned* p)              { return __hip_atomic_load(p, __ATOMIC_RELAXED, __HIP_MEMORY_SCOPE_AGENT); }
__device__ __forceinline__ unsigned xb_add(unsigned* p, unsigned v) { return __hip_atomic_fetch_add(p, v, __ATOMIC_RELAXED, __HIP_MEMORY_SCOPE_AGENT); }
__device__ __forceinline__ unsigned xb_xcc_id() { return (unsigned)__builtin_amdgcn_s_getreg((3 << 11) | 20) & 0xFu; }
#define XB_SPIN(cond, bar) do { unsigned _sp = 0; while (cond) { __builtin_amdgcn_s_sleep(1); \
    if ((++_sp & 255u) == 0u) { if (xb_ld(&(bar)[XB_TMO])) break; if (_sp > XB_SPIN_CAP) { atomicAdd(&(bar)[XB_TMO], 1u); break; } } } } while (0)
struct XcdBarrier { unsigned* bar; unsigned x; volatile LAS unsigned* st; };
__device__ __forceinline__ XcdBarrier xcd_barrier_post(unsigned* bar, volatile LAS unsigned* st) {
    XcdBarrier b; b.bar = bar; b.x = xb_xcc_id(); b.st = st;
    if (threadIdx.x == 0) (void)xb_add(&bar[XB_XCNT(b.x)], 1u);
    return b;
}
__device__ __forceinline__ void xcd_barrier_complete(unsigned* bar, unsigned x, unsigned& nloc, unsigned& nx) {
    const unsigned G = gridDim.x * gridDim.y * gridDim.z;
    unsigned sum, cnt, mine, sp = 0u;
    for (;;) {
        sum = 0u; cnt = 0u; mine = 0u;
#pragma unroll
        for (unsigned j = 0; j < 16; ++j) { const unsigned c = xb_ld(&bar[XB_XCNT(j)]); sum += c; cnt += (c > 0u) ? 1u : 0u; mine = (j == x) ? c : mine; }
        if (sum == G) break;
        __builtin_amdgcn_s_sleep(1);
        if ((++sp & 255u) == 0u) { if (xb_ld(&bar[XB_TMO])) break; if (sp > XB_SPIN_CAP) { atomicAdd(&bar[XB_TMO], 1u); break; } }
    }
    nloc = mine > 0u ? mine : 1u; nx = cnt > 0u ? cnt : 1u;
}
__device__ __forceinline__ void xcd_barrier(const XcdBarrier& b) {
    asm volatile("s_waitcnt vmcnt(0)" ::: "memory");
    __syncthreads();
    if (threadIdx.x == 0) {
        unsigned* bar = b.bar;
        __builtin_amdgcn_s_waitcnt(0);
        unsigned nloc = b.st[0], nx = b.st[1];
        if (nloc == 0u) { xcd_barrier_complete(bar, b.x, nloc, nx); b.st[0] = nloc; b.st[1] = nx; }
        const unsigned old = xb_add(&bar[XB_XSUB(b.x)], 1u);
        const unsigned gen = old / nloc;
        if (old + 1u == (gen + 1u) * nloc) {
            __builtin_amdgcn_fence(__ATOMIC_RELEASE, "agent");
            asm volatile("s_waitcnt vmcnt(0)" ::: "memory");
            const unsigned og = xb_add(&bar[XB_TOP], 1u);
            const unsigned tg = og / nx;
            if (og + 1u == (tg + 1u) * nx) xb_add(&bar[XB_TOPGEN], 1u);
            else XB_SPIN(xb_ld(&bar[XB_TOPGEN]) == tg, bar);
            __builtin_amdgcn_fence(__ATOMIC_ACQUIRE, "agent");
            xb_add(&bar[XB_XGEN(b.x)], 1u);
            asm volatile("s_waitcnt vmcnt(0)" ::: "memory");
        } else {
            XB_SPIN(xb_ld(&bar[XB_XGEN(b.x)]) == gen, bar);
            __builtin_amdgcn_fence(__ATOMIC_ACQUIRE, "agent");
            asm volatile("s_waitcnt vmcnt(0)" ::: "memory");
        }
    }
    __syncthreads();
}

__global__ void __launch_bounds__(512, 2) mega(Args a) {
    extern __shared__ __attribute__((aligned(16))) unsigned char shm[];
    LAS unsigned char* lds = (LAS unsigned char*)shm;
    cg::grid_group grid = cg::this_grid();
    const int tid = threadIdx.x, wid = tid >> 6, lane = tid & 63, G = gridDim.x, bid = blockIdx.x;
    unsigned char* ws = a.ws; unsigned* ctl = (unsigned*)(ws + WS_CTL);
    bf16_t* XA = (bf16_t*)(ws + WS_XA); bf16_t* T1 = (bf16_t*)(ws + WS_T1); bf16_t* MIX = (bf16_t*)(ws + WS_MIX); float* X1 = (float*)(ws + WS_X1);
    bf16_t* U = (bf16_t*)(ws + WS_U); bf16_t* Qb = (bf16_t*)(ws + WS_Q); bf16_t* Kb = (bf16_t*)(ws + WS_K); bf16_t* Vb = (bf16_t*)(ws + WS_V);
    bf16_t* GC = (bf16_t*)(ws + WS_GC); bf16_t* GA = (bf16_t*)(ws + WS_GA); bf16_t* CACT = (bf16_t*)(ws + WS_CACT); bf16_t* OG = (bf16_t*)(ws + WS_OG); bf16_t* OATT = (bf16_t*)(ws + WS_OATT);
    bf16_t* HID = (bf16_t*)(ws + WS_HID); float* SS1 = (float*)(ws + WS_SS1); float* SS2 = (float*)(ws + WS_SS2); float* ROPE = (float*)(ws + WS_ROPE); float* LSE = (float*)(ws + WS_LSE);
#define PH(p) if (a.ph_lo <= (p) && (p) < a.ph_hi)
#define SEAM(p) if (a.ph_lo <= (p) && (p) + 1 < a.ph_hi) xcd_barrier(xb)

    volatile LAS unsigned* xst = (volatile LAS unsigned*)(lds + LDS_BYTES - 16);
    if (tid == 0) { xst[0] = 0u; xst[1] = 0u; LAS unsigned long long* pt = (LAS unsigned long long*)(lds + LDS_BYTES - 128);
        pt[0] = (unsigned long long)a.in[3]; pt[1] = (unsigned long long)a.in[4]; pt[2] = (unsigned long long)a.in[5]; pt[3] = (unsigned long long)a.in[6]; pt[4] = (unsigned long long)a.in[7]; pt[5] = (unsigned long long)a.in[8]; }
    CacheStream cs; cs.ci = 0; cs.c = bid; cs.step = G; cs.out = a.out; cs.sbase = nullptr; cs.dbase = nullptr; cs.ncache = 0; cs.cur_src = nullptr; cs.cur_dst = nullptr; cs.inflight = false; NoStream ns;
    __syncthreads();
    cs.setup(lds);
    XcdBarrier xb = xcd_barrier_post((unsigned*)(ws + WS_CTL), xst);
    if (a.ph_hi > 1000) grid.sync();
    PH(0) {
        const int gt = bid * 512 + tid, GT = G * 512;
        for (int i = gt; i < 2 * 16384; i += GT) __hip_atomic_store((float*)(ws + WS_SS1) + i, 0.f, __ATOMIC_RELAXED, __HIP_MEMORY_SCOPE_AGENT);
        for (int i = gt; i < 2052 * 16; i += GT) {
            const int pi = i >> 4, fi = i & 15; const double pos = pi < 2048 ? (double)pi : (double)(8192 + pi - 2048);
            const double rev = pos * ROPE_INV[fi] * 0.15915494309189535; const float fr_ = (float)(rev - floor(rev));
            ROPE[2 * i] = __builtin_amdgcn_cosf(fr_); ROPE[2 * i + 1] = __builtin_amdgcn_sinf(fr_);
        }
        for (int row = bid * 8 + wid; row < MR; row += G * 8) {
            const float* src = row < NPR ? a.in[0] + (size_t)row * DM : a.in[1] + (size_t)(row - NPR) * DM;
            f32x4 v[8]; float ss = 0.f;
#pragma unroll
            for (int i = 0; i < 4; ++i) { v[2 * i] = *(const f32x4*)(src + (i * 64 + lane) * 8); v[2 * i + 1] = *(const f32x4*)(src + (i * 64 + lane) * 8 + 4); }
#pragma unroll
            for (int i = 0; i < 8; ++i) ss += v[i][0] * v[i][0] + v[i][1] * v[i][1] + v[i][2] * v[i][2] + v[i][3] * v[i][3];
#pragma unroll
            for (int o = 1; o < 64; o <<= 1) ss += __shfl_xor(ss, o);
            const float r = __builtin_amdgcn_rsqf(ss * (1.0f / DM) + NORM_EPS);
#pragma unroll
            for (int i = 0; i < 4; ++i) { const int c = (i * 64 + lane) * 8; const f32x4 g0 = *(const f32x4*)(a.in[9] + c), g1 = *(const f32x4*)(a.in[9] + c + 4);
                *(u32x4*)(XA + (size_t)row * DM + c) = pack8(v[2 * i] * r * g0, v[2 * i + 1] * r * g1); }
        }
        {
#define WCOPY(KIND, w0, w1, ldw, K, Np, ksc, dst) do { const int npt_ = (Np) / 256, nu_ = ((K) / 64) * npt_; \
                for (int uidx = bid; uidx < nu_; uidx += G) wcopy_unit<KIND>((LAS float*)lds, w0, w1, ldw, K, ksc, dst, uidx / npt_, uidx % npt_); } while (0)
            WCOPY(1, a.in[10], nullptr, INC, DM, INC, nullptr, (bf16_t*)(ws + WS_WIN));
            WCOPY(0, a.in[16], nullptr, DM, DC, DM, nullptr, (bf16_t*)(ws + WS_WPW));
            WCOPY(0, a.in[18], nullptr, DM, AO, DM, nullptr, (bf16_t*)(ws + WS_WOA));
            WCOPY(0, a.in[19], nullptr, DM, DM, DM, nullptr, (bf16_t*)(ws + WS_WOUT));
            WCOPY(2, a.in[21], a.in[22], FH, DM, 2 * FH, a.in[20], (bf16_t*)(ws + WS_WGU));
            WCOPY(0, a.in[23], nullptr, DM, FH, DM, nullptr, (bf16_t*)(ws + WS_WDN));
#undef WCOPY
        }
        for (int i = gt; i < 32 * 26 * 256; i += GT) { const int bb = i / (26 * 256), rr = i - bb * 26 * 256; ((f32x4*)(a.out + OFF_CONVS))[(size_t)bb * 30 * 256 + rr] = ((const f32x4*)a.in[2])[(size_t)bb * 30 * 256 + 4 * 256 + rr]; }
    }
    SEAM(0);
    PH(1) {
        pg8::Gemm gm{XA, (const bf16_t*)(ws + WS_WIN), NPR, INC, DM};
        pg8::StaticOrder S; S.init(NPR, INC, G, bid);
        TileEpi<EpiIn> E{EpiIn{U, Qb, Kb, Vb, GC, GA, a.out, a.in[11], ROPE}};
        pg8::gemm_phase(lds, gm, S, E, cs);
        skinny_phase(lds, XA, (const bf16_t*)(ws + WS_WIN), DM, INC, E.e, 64);
    }
    SEAM(1);
    PH(2) {
        {
            const int nmine = (768 + 192 - bid + G - 1) / G;
            for (int i = 0; i < nmine; ++i) {
                const int k = (i + bid) % nmine, u = bid + k * G;
                if (u < 768) attn_prompt_unit(lds, u, Qb, Kb, Vb, OG, LSE);
                else attn_sample_unit(u - 768, a, Qb, OG, LSE);
            }
        }
        if (bid < 544) {
            f32x2 wd[31];
#pragma unroll
            for (int j = 0; j < 31; ++j) wd[j] = *(const f32x2*)(a.in[12] + j * 1024 + tid * 2);
            const f32x2 bdw = *(const f32x2*)(a.in[13] + tid * 2), lng = *(const f32x2*)(a.in[14] + tid * 2), lnb = *(const f32x2*)(a.in[15] + tid * 2);
            for (int u = G - 1 - bid; u < 544; u += G) conv_unit(lds, u, a, U, CACT, wd, bdw, lng, lnb);
        }
    }
    SEAM(2);
    PH(3) {
        for (int u = bid; u < MR / 32; u += G) {
#pragma unroll
            for (int i = 0; i < 4; ++i) {
                const int idx = tid + 512 * i, row = u * 32 + (idx >> 6), ch = idx & 63, hs = ch >> 4;
                const float l0 = LSE[((size_t)0 * MP + row) * 4 + hs], l1 = LSE[((size_t)1 * MP + row) * 4 + hs], l2 = LSE[((size_t)2 * MP + row) * 4 + hs];
                const float mx = fmaxf(l0, fmaxf(l1, l2)), e0 = __expf(l0 - mx), e1 = __expf(l1 - mx), e2 = __expf(l2 - mx), inv = 1.0f / (e0 + e1 + e2);
                f32x4 a0, b0, a1, b1, a2, b2;
                unpack8(*(const u32x4*)(OG + ((size_t)0 * MP + row) * AO + ch * 8), a0, b0);
                unpack8(*(const u32x4*)(OG + ((size_t)1 * MP + row) * AO + ch * 8), a1, b1);
                unpack8(*(const u32x4*)(OG + ((size_t)2 * MP + row) * AO + ch * 8), a2, b2);
                *(u32x4*)(OATT + (size_t)row * AO + ch * 8) = pack8((a0 * e0 + a1 * e1 + a2 * e2) * inv, (b0 * e0 + b1 * e1 + b2 * e2) * inv);
            }
        }
    }
    SEAM(3);
    PH(4) {
        pg8::StaticOrder S; S.init(NPR, DM, G, bid);
        TileEpi<EpiPw> E1{EpiPw{T1, GC, a.in[17]}}; TileEpi<EpiOa> E2{EpiOa{T1, GA, MIX}};
        { pg8::Gemm gm{CACT, (const bf16_t*)(ws + WS_WPW), NPR, DM, DC}; pg8::gemm_phase(lds, gm, S, E1, ns); }
        { pg8::Gemm gm{OATT, (const bf16_t*)(ws + WS_WOA), NPR, DM, AO}; pg8::gemm_phase(lds, gm, S, E2, ns); }
        skinny_phase(lds, CACT, (const bf16_t*)(ws + WS_WPW), DC, DM, E1.e, 0);
        skinny_phase(lds, OATT, (const bf16_t*)(ws + WS_WOA), AO, DM, E2.e, 0);
    }
    SEAM(4);
    PH(5) {
        pg8::Gemm gm{MIX, (const bf16_t*)(ws + WS_WOUT), NPR, DM, DM};
        pg8::StaticOrder S; S.init(NPR, DM, G, bid);
        TileEpi<EpiRes> E{EpiRes{a.in[0], a.in[1], (size_t)NPR, nullptr, XA, SS1, nullptr}};
        pg8::gemm_phase(lds, gm, S, E, ns);
        skinny_phase(lds, MIX, (const bf16_t*)(ws + WS_WOUT), DM, DM, E.e, 0);
    }
    SEAM(5);
    PH(6) {
        pg8::Gemm gm{XA, (const bf16_t*)(ws + WS_WGU), NPR, 2 * FH, DM};
        pg8::StaticOrder S; S.init(NPR, 2 * FH, G, bid);
        TileEpi<EpiGu> E{EpiGu{SS1, HID}};
        pg8::gemm_phase(lds, gm, S, E, cs);
        skinny_phase(lds, XA, (const bf16_t*)(ws + WS_WGU), DM, 2 * FH, E.e, 128);
    }
    SEAM(6);
    PH(7) {
        pg8::Gemm gm{HID, (const bf16_t*)(ws + WS_WDN), NPR, DM, FH};
        pg8::StaticOrder S; S.init(NPR, DM, G, bid);
        TileEpi<EpiRes> E{EpiRes{nullptr, nullptr, (size_t)0, a.out, nullptr, SS2, XA}};
        if (G == 256) {
            EpiFinalTile EF{XA, a.out, SS2, ctl, a.in[24]}; pg8::gemm_phase(lds, gm, S, EF, ns);
            EpiFinalRow ER{XA, a.out, SS2, ctl, a.in[24]}; skinny_phase(lds, HID, (const bf16_t*)(ws + WS_WDN), FH, DM, ER, 0);
        } else {
            pg8::gemm_phase(lds, gm, S, E, ns);
            skinny_phase(lds, HID, (const bf16_t*)(ws + WS_WDN), FH, DM, E.e, 0);
        }
        while (cs.ci < 6) {
            f32x4 v[8]; float* d[8];
#pragma unroll
            for (int k = 0; k < 8; ++k) { d[k] = nullptr; if (cs.ci < 6) { cs.decode_next(lds); d[k] = cs.cur_dst; v[k] = __builtin_nontemporal_load((const f32x4*)(cs.cur_src + tid * 4)); } }
#pragma unroll
            for (int k = 0; k < 8; ++k) if (d[k]) __builtin_nontemporal_store(v[k], (f32x4*)(d[k] + tid * 4));
        }
    }
    if (G != 256) {
    SEAM(7);
    PH(8) {
        for (int row = bid * 8 + wid; row < MR; row += G * 8) {
            float* p = a.out + (size_t)row * DM;
            const float r = __builtin_amdgcn_rsqf(SS2[row] * (1.0f / DM) + NORM_EPS);
#pragma unroll
            for (int i = 0; i < 8; ++i) { const int c = (i * 64 + lane) * 4; *(f32x4*)(p + c) = *(const f32x4*)(p + c) * r * *(const f32x4*)(a.in[24] + c); }
        }
    }
    }
}

extern "C" void kernel_launch(void* const* d_in, const int* in_sizes, int n_in, void* d_out, int out_size, void* d_ws, size_t ws_size, hipStream_t stream) {
    static int grid = 0;
    if (grid == 0) {
        if (n_in != 25 || ws_size < WS_END) { fprintf(stderr, "kernel_launch: need 25 inputs and %zu bytes of workspace; got %d, %zu\n", (size_t)WS_END, n_in, ws_size); grid = -1; return; }
        int dev = 0, cus = 0, per_cu = 0;
        (void)hipGetDevice(&dev); (void)hipDeviceGetAttribute(&cus, hipDeviceAttributeMultiprocessorCount, dev);
        if (hipFuncSetAttribute((const void*)mega, hipFuncAttributeMaxDynamicSharedMemorySize, LDS_BYTES) != hipSuccess) { fprintf(stderr, "kernel_launch: hipFuncSetAttribute failed\n"); grid = -1; return; }
        if (hipOccupancyMaxActiveBlocksPerMultiprocessor(&per_cu, (const void*)mega, 512, LDS_BYTES) != hipSuccess || per_cu < 1) { fprintf(stderr, "kernel_launch: occupancy query says %d\n", per_cu); per_cu = 1; }
        (void)hipGetLastError();
        grid = cus * 1;
        if (grid > 512) grid = 512;
    }
    if (grid < 0) return;
    (void)hipMemsetAsync((char*)d_ws + WS_CTL, 0, 40960, stream);
    Args a{};
    for (int i = 0; i < 25; ++i) a.in[i] = (const float*)d_in[i];
    a.out = (float*)d_out; a.ws = (unsigned char*)d_ws;
#if MK_SPLIT
    for (int p = 0; p < 9; ++p) { a.ph_lo = p; a.ph_hi = p + 1; hipLaunchKernelGGL(mega, dim3(grid), dim3(512), LDS_BYTES, stream, a); }
#else
    a.ph_lo = 0; a.ph_hi = 9;
    void* args[] = {&a};
    hipError_t e = hipLaunchCooperativeKernel((const void*)mega, dim3(grid), dim3(512), args, LDS_BYTES, stream);
    if (e != hipSuccess) fprintf(stderr, "kernel_launch: cooperative launch failed: %s (grid %d)\n", hipGetErrorString(e), grid);
#endif
}
```

```cpp
#include <hip/hip_runtime.h>
#include <hip/hip_cooperative_groups.h>
#include <cstdio>
#include <cstdint>
namespace cg = cooperative_groups;

#ifndef MK_SPLIT
#define MK_SPLIT 0
#endif

#define LAS __attribute__((address_space(3)))
typedef unsigned short bf16_t;
typedef short bf16x8 __attribute__((ext_vector_type(8)));
typedef short s16x4 __attribute__((ext_vector_type(4)));
typedef float f32x4 __attribute__((ext_vector_type(4)));
typedef float f32x2 __attribute__((ext_vector_type(2)));
typedef unsigned u32x4 __attribute__((ext_vector_type(4)));
typedef unsigned u32x2 __attribute__((ext_vector_type(2)));

constexpr int DM = 2048, NPR = 8192, MR = 8320, MP = 8448;
constexpr int DC = 1024, AW = 1536, AO = 512, FH = 5632, INC = 10752;
constexpr float NORM_EPS = 1e-6f, LN_EPS = 1e-5f;
constexpr float ATT_SCALE_LOG2E = 0.08838834764831845f * 1.4426950408889634f;
constexpr float LN2F = 0.6931471805599453f;

constexpr size_t OFF_YP = 0, OFF_YS = (size_t)NPR * DM, OFF_CONVP = (size_t)MR * DM, OFF_CONVS = OFF_CONVP + 4 * 30 * 1024, OFF_KV = OFF_CONVS + 32 * 30 * 1024;
__host__ __device__ constexpr size_t kv_group_base(int g) { return OFF_KV + (g == 0 ? 0 : (g == 1 ? (size_t)2 * 36 * 128 * 512 : (size_t)2 * 36 * (128 + 512) * 512)); }

constexpr size_t MiB = 1u << 20;
constexpr size_t WS_CTL = 0;
constexpr size_t WS_SS1 = 1 * MiB, WS_SS2 = WS_SS1 + 64 * 1024;
constexpr size_t WS_ROPE = 2 * MiB;
constexpr size_t WS_LSE = 3 * MiB;
constexpr size_t WS_WIN = 4 * MiB;
constexpr size_t WS_WPW = WS_WIN + (size_t)INC * DM * 2;
constexpr size_t WS_WOA = WS_WPW + (size_t)DM * DC * 2;
constexpr size_t WS_WOUT = WS_WOA + (size_t)DM * AO * 2;
constexpr size_t WS_WGU = WS_WOUT + (size_t)DM * DM * 2;
constexpr size_t WS_WDN = WS_WGU + (size_t)2 * FH * DM * 2;
constexpr size_t WS_XA = WS_WDN + (size_t)DM * FH * 2;
constexpr size_t WS_T1 = WS_XA + (size_t)MP * DM * 2;
constexpr size_t WS_MIX = WS_T1 + (size_t)MP * DM * 4;
constexpr size_t WS_X1 = WS_MIX + (size_t)MP * DM * 2;
constexpr size_t WS_C = WS_X1 + (size_t)MP * DM * 4;
constexpr size_t WS_U = WS_C;
constexpr size_t WS_Q = WS_U + (size_t)MP * DC * 2;
constexpr size_t WS_K = WS_Q + (size_t)MP * AW * 2;
constexpr size_t WS_V = WS_K + (size_t)MP * AW * 2;
constexpr size_t WS_GC = WS_V + (size_t)MP * AW * 2;
constexpr size_t WS_GA = WS_GC + (size_t)MP * DM * 2;
constexpr size_t WS_CACT = WS_GA + (size_t)MP * DM * 2;
constexpr size_t WS_OG = WS_CACT + (size_t)MP * DC * 2;
constexpr size_t WS_OATT = WS_OG + (size_t)3 * MP * AO * 2;
constexpr size_t WS_CEND = WS_OATT + (size_t)MP * AO * 2;
constexpr size_t WS_HID = WS_C;
static_assert(WS_HID + (size_t)MP * FH * 2 <= WS_CEND, "HID overlay fits region C");
constexpr size_t WS_END = WS_CEND;

constexpr int LDS_BYTES = 147456;

struct Args { const float* in[25]; float* out; unsigned char* ws; int ph_lo, ph_hi; };

__device__ __forceinline__ unsigned cvt_pk_bf16(float lo, float hi) { unsigned r; asm("v_cvt_pk_bf16_f32 %0, %1, %2" : "=v"(r) : "v"(lo), "v"(hi)); return r; }
__device__ __forceinline__ float bf_lo(unsigned w) { return __uint_as_float(w << 16); }
__device__ __forceinline__ float bf_hi(unsigned w) { return __uint_as_float(w & 0xffff0000u); }
__device__ __forceinline__ float sigmoidf_(float x) { return __builtin_amdgcn_rcpf(1.0f + __expf(-x)); }
__device__ __forceinline__ u32x4 pack8(const f32x4& a, const f32x4& b) { u32x4 w; w.x = cvt_pk_bf16(a[0], a[1]); w.y = cvt_pk_bf16(a[2], a[3]); w.z = cvt_pk_bf16(b[0], b[1]); w.w = cvt_pk_bf16(b[2], b[3]); return w; }
__device__ __forceinline__ void unpack8(const u32x4& w, f32x4& a, f32x4& b) { a[0] = bf_lo(w.x); a[1] = bf_hi(w.x); a[2] = bf_lo(w.y); a[3] = bf_hi(w.y); b[0] = bf_lo(w.z); b[1] = bf_hi(w.z); b[2] = bf_lo(w.w); b[3] = bf_hi(w.w); }
__host__ __device__ __forceinline__ int perm32(int rho) { const int n = rho >> 4, i = rho & 15; return 8 * (i >> 2) + 4 * n + (i & 3); }

constexpr int CS_NCHUNK = 42816, CS_LDS_OFF = 131072;
struct CacheStream {
    int ci, c, step;
    const float* out;
    const float* sbase; float* dbase; int ncache;
    const float* cur_src; float* cur_dst;
    bool inflight;
    __device__ __forceinline__ void setup(LAS unsigned char* lds) {
        while (ci < 6) { const int cpb = (32 << (2 * (ci >> 1))) - 1; ncache = 32 * cpb; if (c < ncache) break; c -= ncache; ++ci; }
        if (ci < 6) {
            const int g = ci >> 1, Wb = 128 << (2 * g);
            const unsigned long long sp = ((const LAS unsigned long long*)(lds + LDS_BYTES - 128))[ci];
            const unsigned lo = __builtin_amdgcn_readfirstlane((unsigned)sp), hi = __builtin_amdgcn_readfirstlane((unsigned)(sp >> 32));
            sbase = (const float*)(((unsigned long long)hi << 32) | lo);
            dbase = const_cast<float*>(out) + kv_group_base(g) + ((ci & 1) ? (size_t)40 * Wb * 512 : (size_t)4 * Wb * 512);
        }
    }
    __device__ __forceinline__ void decode_next(LAS unsigned char* lds) {
        const int g = ci >> 1, bb = g == 0 ? c / 31 : (g == 1 ? c / 127 : c / 511);
        cur_src = sbase + (size_t)(c + bb + 1) * 2048; cur_dst = dbase + (size_t)(c + bb) * 2048;
        c += step; if (c >= ncache) { c -= ncache; ++ci; setup(lds); }
    }
    __device__ __forceinline__ void load(LAS unsigned char* lds, int tid, unsigned ldsw) {
        inflight = ci < 6;
        if (inflight) { decode_next(lds);
            __builtin_amdgcn_global_load_lds((const unsigned*)(cur_src + tid * 4), (LAS unsigned*)(lds + CS_LDS_OFF + ldsw), 16, 0, 2  ); }
    }
    __device__ __forceinline__ void store(LAS unsigned char* lds, int tid) {
        if (inflight) { const f32x4 v = *(const LAS f32x4*)(lds + CS_LDS_OFF + tid * 16); __builtin_nontemporal_store(v, (f32x4*)(cur_dst + tid * 4)); }
    }
};
struct NoStream {
    __device__ __forceinline__ void load(LAS unsigned char*, int, unsigned) {}
    __device__ __forceinline__ void store(LAS unsigned char*, int) {}
};

namespace pg8 {
constexpr int BM = 256, BK = 64, HALF = 128, HTB = HALF * BK * 2, STAGE_BYTES = 8 * HTB, NXCD = 8, WGM = 8;
__host__ __device__ __forceinline__ int lds_byte(int r, int c) { const int st = (r >> 4) * 2 + (c >> 5), rr = r & 15, cc = c & 31, ob = rr * 64 + cc * 2; return st * 1024 + (ob ^ (((ob >> 9) & 1) << 5)); }
__host__ __device__ __forceinline__ void stage_rc(int b, int& R, int& C) { const int st = b / 1024, sb = b % 1024, swz = sb ^ (((sb >> 9) & 1) << 5); R = (st >> 1) * 16 + swz / 64; C = (st & 1) * 32 + (swz % 64) / 2; }
struct Unit { int pm, pn; };
struct Gemm { const bf16_t* A; const bf16_t* Bt; int M, N, K; };
struct StaticOrder {
    int nM, nN, nwg, G, c;
    __host__ __device__ void init(int M, int N, int G_, int c_) { nM = M / BM; nN = N / BM; nwg = nM * nN; G = G_; c = c_; }
    __host__ __device__ bool next(int i, Unit& u) const {
        const long L = (long)i * G + c; if (L >= nwg) return false;
        int wgid = (int)L; { const int q = nwg / NXCD, r = nwg % NXCD, xcd = wgid % NXCD, off = wgid / NXCD; wgid = (xcd < r ? xcd * (q + 1) : r * (q + 1) + (xcd - r) * q) + off; }
        const int nig = WGM * nN, gid = wgid / nig, fm = gid * WGM, gsz = (nM - fm) < WGM ? (nM - fm) : WGM;
        u.pm = fm + ((wgid % nig) % gsz); u.pn = (wgid % nig) / gsz; return true;
    }
};
template <class Epi, class Cp>
__device__ __forceinline__ void gemm_phase(LAS unsigned char* lds, const Gemm g, const StaticOrder& S, const Epi& E, Cp& cp) {
    const int tid = threadIdx.x, wid = __builtin_amdgcn_readfirstlane(tid >> 6), lane = tid & 63, wr = wid >> 2, wc = wid & 3, fr = lane & 15, fq = lane >> 4;
    const int K = g.K, nt = K / BK;
    unsigned voffA[2];
#pragma unroll
    for (int i = 0; i < 2; ++i) { int R, C; stage_rc(tid * 16 + i * 8192, R, C); voffA[i] = (unsigned)(R * K + C) * 2u; }
    const size_t kstep = (size_t)(BK * 2);
    const size_t hstep = (size_t)HALF * K * 2;
    const size_t tstep = 2 * hstep;
    const unsigned ldsw = (unsigned)wid * 1024u;
    const int aoff = lds_byte(wr * 64 + fr, fq * 8), boff = lds_byte(wc * 32 + fr, fq * 8);
#define PG8_SA(b, h) (((b) * 2 + (h)) * HTB)
#define PG8_SB(b, h) ((4 + (b) * 2 + (h)) * HTB)
#define PG8_STAGE(bufoff, gbase, voff) do { _Pragma("unroll") for (int _i = 0; _i < 2; ++_i) \
        __builtin_amdgcn_global_load_lds((const unsigned*)((const char*)(gbase) + (voff)[_i]), (LAS unsigned*)(lds + (bufoff) + ldsw + _i * 8192), 16, 0, 0); } while (0)
#define PG8_LDA(dst, b, h) do { _Pragma("unroll") for (int m = 0; m < 4; ++m) _Pragma("unroll") for (int k = 0; k < 2; ++k) dst[m][k] = *(const LAS bf16x8*)(lds + PG8_SA(b, h) + aoff + m * 2048 + k * 1024); } while (0)
#define PG8_LDB(dst, b, h) do { _Pragma("unroll") for (int n = 0; n < 2; ++n) _Pragma("unroll") for (int k = 0; k < 2; ++k) dst[n][k] = *(const LAS bf16x8*)(lds + PG8_SB(b, h) + boff + n * 2048 + k * 1024); } while (0)
#define PG8_MMA(ai, bj, At, Bt) do { __builtin_amdgcn_s_setprio(1); _Pragma("unroll") for (int m = 0; m < 4; ++m) _Pragma("unroll") for (int n = 0; n < 2; ++n) _Pragma("unroll") for (int k = 0; k < 2; ++k) \
        acc[ai][bj][m][n] = __builtin_amdgcn_mfma_f32_16x16x32_bf16(Bt[n][k], At[m][k], acc[ai][bj][m][n], 0, 0, 0); __builtin_amdgcn_s_setprio(0); } while (0)
#define PG8_WAIT_V(n) asm volatile("s_waitcnt vmcnt(" #n ")" ::: "memory")
#define PG8_WAIT_L(n) asm volatile("s_waitcnt lgkmcnt(" #n ")" ::: "memory")
#define PG8_BAR __builtin_amdgcn_s_barrier()
#define PG8_SCHED __builtin_amdgcn_sched_barrier(0)
    Unit cur, nxt; int ui = 0;
    if (!S.next(0, cur)) return;
    f32x4 acc[2][2][4][2];
#pragma unroll
    for (int a = 0; a < 2; ++a)
#pragma unroll
        for (int b = 0; b < 2; ++b)
#pragma unroll
            for (int m = 0; m < 4; ++m)
#pragma unroll
                for (int n = 0; n < 2; ++n) acc[a][b][m][n] = (f32x4){0.f, 0.f, 0.f, 0.f};
    bf16x8 At[4][2], B0[2][2], B1[2][2];
    const char* cA = (const char*)g.A + (size_t)cur.pm * tstep; const char* cB = (const char*)g.Bt + (size_t)cur.pn * tstep;
    PG8_STAGE(PG8_SB(0, 0), cB, voffA); PG8_STAGE(PG8_SA(0, 0), cA, voffA); PG8_STAGE(PG8_SB(0, 1), cB + hstep, voffA); PG8_STAGE(PG8_SA(0, 1), cA + hstep, voffA);
    if (wr == 1) PG8_BAR;
    PG8_WAIT_V(4); PG8_BAR;
    PG8_STAGE(PG8_SB(1, 0), cB + kstep, voffA); PG8_STAGE(PG8_SA(1, 0), cA + kstep, voffA); PG8_STAGE(PG8_SB(1, 1), cB + hstep + kstep, voffA);
    PG8_WAIT_V(6); PG8_BAR;
    for (;;) {
        const bool has_next = S.next(ui + 1, nxt);
        const char* nA = has_next ? (const char*)g.A + (size_t)nxt.pm * tstep : cA; const char* nB = has_next ? (const char*)g.Bt + (size_t)nxt.pn * tstep : cB;
        for (int t = 0; t < nt; t += 2) {
            const bool last = (t == nt - 2);
            const char* a1 = cA + (size_t)(t + 1) * kstep;
            const char* a2 = last ? nA : cA + (size_t)(t + 2) * kstep; const char* b2 = last ? nB : cB + (size_t)(t + 2) * kstep;
            const char* a3 = a2 + kstep; const char* b3 = b2 + kstep;
            PG8_LDB(B0, 0, 0); PG8_SCHED; PG8_LDA(At, 0, 0); PG8_STAGE(PG8_SA(1, 1), a1 + hstep, voffA);
            PG8_WAIT_L(8); PG8_BAR; PG8_WAIT_L(0); PG8_MMA(0, 0, At, B0); PG8_BAR; PG8_SCHED;
            PG8_LDB(B1, 0, 1); PG8_STAGE(PG8_SB(0, 0), b2, voffA);
            PG8_BAR; PG8_WAIT_L(0); PG8_MMA(0, 1, At, B1); PG8_BAR;
            PG8_LDA(At, 0, 1); PG8_STAGE(PG8_SA(0, 0), a2, voffA);
            PG8_BAR; PG8_WAIT_L(0); PG8_MMA(1, 0, At, B0); PG8_BAR; PG8_SCHED;
            PG8_STAGE(PG8_SB(0, 1), b2 + hstep, voffA);
            PG8_WAIT_V(6); cp.load(lds, tid, ldsw); PG8_BAR; PG8_MMA(1, 1, At, B1); PG8_BAR;
            PG8_LDB(B0, 1, 0); PG8_SCHED; PG8_LDA(At, 1, 0); PG8_STAGE(PG8_SA(0, 1), a2 + hstep, voffA);
            PG8_WAIT_L(8); PG8_BAR; PG8_WAIT_L(0); PG8_MMA(0, 0, At, B0); PG8_BAR; PG8_SCHED;
            PG8_LDB(B1, 1, 1); PG8_STAGE(PG8_SB(1, 0), b3, voffA);
            PG8_BAR; PG8_WAIT_L(0); PG8_MMA(0, 1, At, B1); PG8_BAR;
            PG8_LDA(At, 1, 1); PG8_STAGE(PG8_SA(1, 0), a3, voffA);
            PG8_BAR; PG8_WAIT_L(0); PG8_MMA(1, 0, At, B0); PG8_BAR; PG8_SCHED;
            PG8_STAGE(PG8_SB(1, 1), b3 + hstep, voffA);
            PG8_WAIT_V(6); PG8_BAR; PG8_MMA(1, 1, At, B1); cp.store(lds, tid); PG8_BAR;
        }
        E(acc, cur, wr, wc, fr, fq);
        if (!has_next) break;
#pragma unroll
        for (int a = 0; a < 2; ++a)
#pragma unroll
            for (int b = 0; b < 2; ++b)
#pragma unroll
                for (int m = 0; m < 4; ++m)
#pragma unroll
                    for (int n = 0; n < 2; ++n) acc[a][b][m][n] = (f32x4){0.f, 0.f, 0.f, 0.f};
        cur = nxt; cA = nA; cB = nB; ++ui;
    }
    PG8_WAIT_V(0);
    if (wr == 0) PG8_BAR;
    PG8_BAR;
#undef PG8_SA
#undef PG8_SB
#undef PG8_STAGE
#undef PG8_LDA
#undef PG8_LDB
#undef PG8_MMA
#undef PG8_WAIT_V
#undef PG8_WAIT_L
#undef PG8_BAR
#undef PG8_SCHED
}
}
using pg8::Unit;

struct RowInfo { int b, t, pidx; bool prompt; };
__device__ __forceinline__ RowInfo row_info(int row) { RowInfo r; r.prompt = row < NPR; if (r.prompt) { r.b = row >> 11; r.t = row & 2047; r.pidx = r.t; } else { const int s = row - NPR; r.b = s >> 2; r.t = s & 3; r.pidx = 2048 + r.t; } return r; }

struct EpiIn {
    bf16_t *U, *Q, *K, *V, *GC, *GA; float* out; const float* bglu; const float* rope;
    __device__ __forceinline__ void kv_out(bool isK, const RowInfo& ri, int head, int dim, const f32x4& v0, const f32x4& v1, bool split16) const {
        const int g = head >> 2, hs = head & 3, win = 128 << (2 * g);
        const size_t gb = kv_group_base(g);
        size_t off;
        if (ri.prompt) { if (ri.t < 2048 - win) return; off = gb + (isK ? 0 : (size_t)36 * win * 512) + ((size_t)(ri.b * win + (ri.t - (2048 - win))) * 4 + hs) * 128 + dim; }
        else off = gb + (isK ? (size_t)4 * win * 512 : (size_t)40 * win * 512) + ((size_t)(ri.b * win + win - 4 + ri.t) * 4 + hs) * 128 + dim;
        __builtin_nontemporal_store(v0, (f32x4*)(out + off)); __builtin_nontemporal_store(v1, (f32x4*)(out + off + (split16 ? 16 : 4)));
    }
    __device__ __forceinline__ void row(int row, int pn, int wc, int fq, const f32x4 (&v)[2][2]) const {
        if (row >= MR) return;
        const RowInfo ri = row_info(row);
        if (pn < 8) {
            const int c0 = pn * 128 + wc * 32 + fq * 8;
            f32x4 uu[2];
#pragma unroll
            for (int n = 0; n < 2; ++n) {
                const f32x4 ba = *(const f32x4*)(bglu + c0 + 4 * n), bb = *(const f32x4*)(bglu + 1024 + c0 + 4 * n);
#pragma unroll
                for (int j = 0; j < 4; ++j) uu[n][j] = (v[0][n][j] + ba[j]) * sigmoidf_(v[1][n][j] + bb[j]);
            }
            *(u32x4*)(U + (size_t)row * DC + c0) = pack8(uu[0], uu[1]);
            if (ri.prompt) { if (ri.t >= 2018) { float* o = out + OFF_CONVP + ((size_t)(ri.b * 30 + ri.t - 2018)) * 1024 + c0; *(f32x4*)o = uu[0]; *(f32x4*)(o + 4) = uu[1]; } }
            else { float* o = out + OFF_CONVS + ((size_t)(ri.b * 30 + 26 + ri.t)) * 1024 + c0; *(f32x4*)o = uu[0]; *(f32x4*)(o + 4) = uu[1]; }
        } else if (pn < 20) {
            const bool isK = pn >= 14; bf16_t* buf = isK ? K : Q; const int hp = (isK ? pn - 14 : pn - 8) * 2;
#pragma unroll
            for (int bj = 0; bj < 2; ++bj) {
                const int head = hp + bj; bf16_t* dst = buf + (size_t)row * AW + head * 128;
                if (wc == 0) {
                    const f32x4 x1 = v[bj][0], x2 = v[bj][1];
                    const float* rp = rope + ((size_t)ri.pidx * 16 + 4 * fq) * 2;
                    const f32x4 cs0 = *(const f32x4*)rp, cs1 = *(const f32x4*)(rp + 4);
                    f32x4 o1, o2;
                    o1[0] = x1[0] * cs0[0] - x2[0] * cs0[1]; o2[0] = x2[0] * cs0[0] + x1[0] * cs0[1];
                    o1[1] = x1[1] * cs0[2] - x2[1] * cs0[3]; o2[1] = x2[1] * cs0[2] + x1[1] * cs0[3];
                    o1[2] = x1[2] * cs1[0] - x2[2] * cs1[1]; o2[2] = x2[2] * cs1[0] + x1[2] * cs1[1];
                    o1[3] = x1[3] * cs1[2] - x2[3] * cs1[3]; o2[3] = x2[3] * cs1[2] + x1[3] * cs1[3];
                    u32x2 w1, w2; w1.x = cvt_pk_bf16(o1[0], o1[1]); w1.y = cvt_pk_bf16(o1[2], o1[3]); w2.x = cvt_pk_bf16(o2[0], o2[1]); w2.y = cvt_pk_bf16(o2[2], o2[3]);
                    *(u32x2*)(dst + 4 * fq) = w1; *(u32x2*)(dst + 16 + 4 * fq) = w2;
                    if (isK) kv_out(true, ri, head, 4 * fq, o1, o2, true);
                } else {
                    const int d0 = wc * 32 + fq * 8;
                    *(u32x4*)(dst + d0) = pack8(v[bj][0], v[bj][1]);
                    if (isK) kv_out(true, ri, head, d0, v[bj][0], v[bj][1], false);
                }
            }
        } else if (pn < 26) {
            const int hp = (pn - 20) * 2, d0 = wc * 32 + fq * 8;
#pragma unroll
            for (int bj = 0; bj < 2; ++bj) {
                const int head = hp + bj;
                *(u32x4*)(V + (size_t)row * AW + head * 128 + d0) = pack8(v[bj][0], v[bj][1]);
                kv_out(false, ri, head, d0, v[bj][0], v[bj][1], false);
            }
        } else {
            bf16_t* buf = pn < 34 ? GC : GA; const int cb = (pn < 34 ? pn - 26 : pn - 34) * 256 + wc * 32 + fq * 8;
#pragma unroll
            for (int bj = 0; bj < 2; ++bj) {
                f32x4 g0, g1;
#pragma unroll
                for (int j = 0; j < 4; ++j) { g0[j] = sigmoidf_(v[bj][0][j]); g1[j] = sigmoidf_(v[bj][1][j]); }
                __builtin_nontemporal_store(pack8(g0, g1), (u32x4*)(buf + (size_t)row * DM + cb + bj * 128));
            }
        }
    }
};
struct EpiPw {
    bf16_t* T1; const bf16_t* GC; const float* bpw;
    __device__ __forceinline__ void row(int row, int pn, int wc, int fq, const f32x4 (&v)[2][2]) const {
        if (row >= MR) return;
#pragma unroll
        for (int bj = 0; bj < 2; ++bj) {
            const int c0 = pn * 256 + bj * 128 + wc * 32 + fq * 8;
            const f32x4 b0 = *(const f32x4*)(bpw + c0), b1 = *(const f32x4*)(bpw + c0 + 4);
            f32x4 g0, g1; unpack8(*(const u32x4*)(GC + (size_t)row * DM + c0), g0, g1);
            *(u32x4*)(T1 + (size_t)row * DM + c0) = pack8((v[bj][0] + b0) * g0, (v[bj][1] + b1) * g1);
        }
    }
};
struct EpiOa {
    const bf16_t* T1; const bf16_t* GA; bf16_t* MIX;
    __device__ __forceinline__ void row(int row, int pn, int wc, int fq, const f32x4 (&v)[2][2]) const {
        if (row >= MR) return;
#pragma unroll
        for (int bj = 0; bj < 2; ++bj) {
            const int c0 = pn * 256 + bj * 128 + wc * 32 + fq * 8;
            f32x4 g0, g1; unpack8(*(const u32x4*)(GA + (size_t)row * DM + c0), g0, g1);
            f32x4 t0, t1; unpack8(*(const u32x4*)(T1 + (size_t)row * DM + c0), t0, t1);
            *(u32x4*)(MIX + (size_t)row * DM + c0) = pack8(t0 + v[bj][0] * g0, t1 + v[bj][1] * g1);
        }
    }
};
struct EpiRes {
    const float* xp; const float* xs; size_t xs_row0;
    float* XO; bf16_t* XB; float* SS; const bf16_t* SB;
    __device__ __forceinline__ void row(int row, int pn, int wc, int fq, const f32x4 (&v)[2][2]) const {
        const bool ok = row < MR;
        float ss = 0.f;
        if (ok) {
            const float* src = row < NPR ? xp + (size_t)row * DM : xs + ((size_t)row - xs_row0) * DM;
#pragma unroll
            for (int bj = 0; bj < 2; ++bj) {
                const int c0 = pn * 256 + bj * 128 + wc * 32 + fq * 8;
                f32x4 r0, r1;
                if (SB) unpack8(*(const u32x4*)(SB + (size_t)row * DM + c0), r0, r1); else { r0 = *(const f32x4*)(src + c0); r1 = *(const f32x4*)(src + c0 + 4); }
                const f32x4 v0 = r0 + v[bj][0], v1 = r1 + v[bj][1];
                if (XO) { float* o = XO + (size_t)row * DM + c0; *(f32x4*)o = v0; *(f32x4*)(o + 4) = v1; }
                if (XB) *(u32x4*)(XB + (size_t)row * DM + c0) = pack8(v0, v1);
                ss += v0[0] * v0[0] + v0[1] * v0[1] + v0[2] * v0[2] + v0[3] * v0[3] + v1[0] * v1[0] + v1[1] * v1[1] + v1[2] * v1[2] + v1[3] * v1[3];
            }
        }
        ss += __shfl_xor(ss, 16); ss += __shfl_xor(ss, 32);
        if (ok && fq == 0) atomicAdd(SS + row, ss);
    }
};
struct EpiGu {
    const float* SS; bf16_t* HID;
    __device__ __forceinline__ void row(int row, int pn, int wc, int fq, const f32x4 (&v)[2][2]) const {
        if (row >= MR) return;
        const int c0 = pn * 128 + wc * 32 + fq * 8;
        const float r = __builtin_amdgcn_rsqf(SS[row] * (1.0f / DM) + NORM_EPS);
        f32x4 h[2];
#pragma unroll
        for (int n = 0; n < 2; ++n)
#pragma unroll
            for (int j = 0; j < 4; ++j) { const float gt = v[0][n][j] * r, up = v[1][n][j] * r; h[n][j] = gt * sigmoidf_(gt) * up; }
        __builtin_nontemporal_store(pack8(h[0], h[1]), (u32x4*)(HID + (size_t)row * FH + c0));
    }
};
constexpr int CW_FIN = 4096;
struct EpiFinalTile {
    const bf16_t* XB; float* out; float* SS; unsigned* cnt; const float* gfin;
    __device__ __forceinline__ void operator()(const f32x4 (&acc)[2][2][4][2], const Unit& u, int wr, int wc, int fr, int fq) const {
        const int rowb = u.pm * 256 + wr * 64 + fr;
#pragma unroll
        for (int ai = 0; ai < 2; ++ai)
#pragma unroll
            for (int m = 0; m < 4; ++m) {
                const int row = rowb + ai * 128 + m * 16; float ss = 0.f;
#pragma unroll
                for (int bj = 0; bj < 2; ++bj) {
                    const int c0 = u.pn * 256 + bj * 128 + wc * 32 + fq * 8;
                    f32x4 r0, r1; unpack8(*(const u32x4*)(XB + (size_t)row * DM + c0), r0, r1);
                    const f32x4 v0 = r0 + acc[ai][bj][m][0], v1 = r1 + acc[ai][bj][m][1];
                    ss += v0[0] * v0[0] + v0[1] * v0[1] + v0[2] * v0[2] + v0[3] * v0[3] + v1[0] * v1[0] + v1[1] * v1[1] + v1[2] * v1[2] + v1[3] * v1[3];
                }
                ss += __shfl_xor(ss, 16); ss += __shfl_xor(ss, 32);
                if (fq == 0) atomicAdd(SS + row, ss);
            }
        asm volatile("s_waitcnt vmcnt(0)" ::: "memory");
        unsigned* c = cnt + CW_FIN + 64 * (2 * u.pm + wr);
        if ((threadIdx.x & 63) == 0) {
            (void)__hip_atomic_fetch_add(c, 1u, __ATOMIC_RELAXED, __HIP_MEMORY_SCOPE_AGENT);
            unsigned sp = 0;
            while (__hip_atomic_load(c, __ATOMIC_RELAXED, __HIP_MEMORY_SCOPE_AGENT) < 32u) { __builtin_amdgcn_s_sleep(1); if (++sp > (1u << 17)) break; }
        }
        asm volatile("" ::: "memory");
#pragma unroll
        for (int ai = 0; ai < 2; ++ai)
#pragma unroll
            for (int m = 0; m < 4; ++m) {
                const int row = rowb + ai * 128 + m * 16;
                const float r = __builtin_amdgcn_rsqf(__hip_atomic_load(SS + row, __ATOMIC_RELAXED, __HIP_MEMORY_SCOPE_AGENT) * (1.0f / DM) + NORM_EPS);
#pragma unroll
                for (int bj = 0; bj < 2; ++bj) {
                    const int c0 = u.pn * 256 + bj * 128 + wc * 32 + fq * 8;
                    f32x4 r0, r1; unpack8(*(const u32x4*)(XB + (size_t)row * DM + c0), r0, r1);
                    const f32x4 g0 = *(const f32x4*)(gfin + c0), g1 = *(const f32x4*)(gfin + c0 + 4);
                    float* o = out + (size_t)row * DM + c0;
                    *(f32x4*)o = (r0 + acc[ai][bj][m][0]) * r * g0; *(f32x4*)(o + 4) = (r1 + acc[ai][bj][m][1]) * r * g1;
                }
            }
    }
};

struct EpiFinalRow {
    const bf16_t* XB; float* out; float* SS; unsigned* cnt; const float* gfin;
    __device__ __forceinline__ void row(int row, int pn, int wc, int fq, const f32x4 (&v)[2][2]) const {
        f32x4 x0[2], x1[2]; float ss = 0.f;
#pragma unroll
        for (int bj = 0; bj < 2; ++bj) {
            const int c0 = pn * 256 + bj * 128 + wc * 32 + fq * 8;
            f32x4 r0, r1; unpack8(*(const u32x4*)(XB + (size_t)row * DM + c0), r0, r1);
            x0[bj] = r0 + v[bj][0]; x1[bj] = r1 + v[bj][1];
            ss += x0[bj][0] * x0[bj][0] + x0[bj][1] * x0[bj][1] + x0[bj][2] * x0[bj][2] + x0[bj][3] * x0[bj][3] + x1[bj][0] * x1[bj][0] + x1[bj][1] * x1[bj][1] + x1[bj][2] * x1[bj][2] + x1[bj][3] * x1[bj][3];
        }
        ss += __shfl_xor(ss, 16); ss += __shfl_xor(ss, 32);
        if (fq == 0) atomicAdd(SS + row, ss);
        asm volatile("s_waitcnt vmcnt(0)" ::: "memory");
        unsigned* c = cnt + CW_FIN + 64 * (64 + ((row - NPR) >> 4));
        if ((threadIdx.x & 63) == 0) {
            (void)__hip_atomic_fetch_add(c, 1u, __ATOMIC_RELAXED, __HIP_MEMORY_SCOPE_AGENT);
            unsigned sp = 0;
            while (__hip_atomic_load(c, __ATOMIC_RELAXED, __HIP_MEMORY_SCOPE_AGENT) < 32u) { __builtin_amdgcn_s_sleep(1); if (++sp > (1u << 17)) break; }
        }
        asm volatile("" ::: "memory");
        const float r = __builtin_amdgcn_rsqf(__hip_atomic_load(SS + row, __ATOMIC_RELAXED, __HIP_MEMORY_SCOPE_AGENT) * (1.0f / DM) + NORM_EPS);
#pragma unroll
        for (int bj = 0; bj < 2; ++bj) {
            const int c0 = pn * 256 + bj * 128 + wc * 32 + fq * 8;
            const f32x4 g0 = *(const f32x4*)(gfin + c0), g1 = *(const f32x4*)(gfin + c0 + 4);
            float* o = out + (size_t)row * DM + c0;
            *(f32x4*)o = x0[bj] * r * g0; *(f32x4*)(o + 4) = x1[bj] * r * g1;
        }
    }
};

template <class Epi> struct TileEpi {
    Epi e;
    __device__ __forceinline__ void operator()(const f32x4 (&acc)[2][2][4][2], const Unit& u, int wr, int wc, int fr, int fq) const {
#pragma unroll
        for (int ai = 0; ai < 2; ++ai)
#pragma unroll
            for (int m = 0; m < 4; ++m) {
                const f32x4 v[2][2] = {{acc[ai][0][m][0], acc[ai][0][m][1]}, {acc[ai][1][m][0], acc[ai][1][m][1]}};
                e.row(u.pm * 256 + ai * 128 + wr * 64 + m * 16 + fr, u.pn, wc, fq, v);
            }
    }
};

template <class Epi>
__device__ __forceinline__ void skinny_phase(LAS unsigned char* lds, const bf16_t* A, const bf16_t* Bt, int K, int N, const Epi& E, int first_block) {
    const int bid = blockIdx.x, G = gridDim.x;
    if (bid < first_block) return;
    const int tid = threadIdx.x, w = tid >> 6, lane = tid & 63, fr = lane & 15, fq = lane >> 4, nb = G - first_block, nsu = (N / 64) * 8;
    const int nks = K / 256;
    for (int su = bid - first_block; su < nsu; su += nb) {
        const int rt = su & 7, pw = su >> 3, pn = pw >> 2, wc = pw & 3;
        const bf16_t* ap = A + (size_t)(NPR + 16 * rt + fr) * K + 8 * fq + w * nks * 32;
        const bf16_t* bp = Bt + (size_t)(pn * 256 + wc * 32 + fr) * K + 8 * fq + w * nks * 32;
        f32x4 acc[4];
#pragma unroll
        for (int i = 0; i < 4; ++i) acc[i] = (f32x4){0.f, 0.f, 0.f, 0.f};
        for (int ks = 0; ks < nks; ks += 2) {
            bf16x8 af[2], bf[2][4];
#pragma unroll
            for (int k2 = 0; k2 < 2; ++k2) {
                af[k2] = *(const bf16x8*)(ap + (ks + k2) * 32);
#pragma unroll
                for (int i = 0; i < 4; ++i) bf[k2][i] = *(const bf16x8*)(bp + (size_t)((i >> 1) * 128 + (i & 1) * 16) * K + (ks + k2) * 32);
            }
#pragma unroll
            for (int k2 = 0; k2 < 2; ++k2)
#pragma unroll
                for (int i = 0; i < 4; ++i) acc[i] = __builtin_amdgcn_mfma_f32_16x16x32_bf16(bf[k2][i], af[k2], acc[i], 0, 0, 0);
        }
        __syncthreads();
#pragma unroll
        for (int i = 0; i < 4; ++i) *(LAS f32x4*)(lds + (w * 4 + i) * 1024 + lane * 16) = acc[i];
        __syncthreads();
        if (w == 0) {
#pragma unroll
            for (int ww = 1; ww < 8; ++ww)
#pragma unroll
                for (int i = 0; i < 4; ++i) acc[i] += *(const LAS f32x4*)(lds + (ww * 4 + i) * 1024 + lane * 16);
            const f32x4 v[2][2] = {{acc[0], acc[1]}, {acc[2], acc[3]}};
            E.row(NPR + 16 * rt + fr, pn, wc, fq, v);
        }
    }
}

template <int KIND>
__device__ __forceinline__ const float* wsrc4(const float* w0, const float* w1, int p) {
    const int rho = p & 31, pb = p & ~31;
    if (KIND == 0) return w0 + pb + perm32(rho);
    if (KIND == 2) { const int pn = p >> 8, bj = (p >> 7) & 1, w = p & 127; const int off = pn * 128 + (w & ~31) + perm32(rho); const float* r0 = w0 + off; const float* r1 = w1 + off; return bj ? r1 : r0; }
    const int pn = p >> 8, bj = (p >> 7) & 1, w = p & 127, wc = w >> 5;
    if (pn < 8) return w0 + bj * 1024 + pn * 128 + wc * 32 + perm32(rho);
    if (pn < 20) return w0 + pb + (wc == 0 ? rho : perm32(rho));
    return w0 + pb + perm32(rho);
}
template <int KIND>
__device__ __forceinline__ void wcopy_unit(LAS float* tile, const float* w0, const float* w1, int ldw, int K, const float* kscale, bf16_t* dst, int kt, int pt) {
    const int tid = threadIdx.x, k0 = kt * 64, p0 = pt * 256;
    const int kk = tid >> 4, c4 = tid & 15;
    f32x4 v[4][2];
#pragma unroll
    for (int sbt = 0; sbt < 4; ++sbt) {
        const float* src = wsrc4<KIND>(w0, w1, p0 + sbt * 64 + 4 * c4);
#pragma unroll
        for (int i = 0; i < 2; ++i) v[sbt][i] = __builtin_nontemporal_load((const f32x4*)(src + (size_t)(k0 + kk + 32 * i) * ldw));
    }
#pragma unroll
    for (int sbt = 0; sbt < 4; ++sbt)
#pragma unroll
        for (int i = 0; i < 2; ++i) {
            f32x4 x = v[sbt][i];
            if (KIND == 2) x = x * kscale[k0 + kk + 32 * i];
            LAS float* d = tile + sbt * (64 * 65) + (kk + 32 * i) * 65 + 4 * c4; d[0] = x[0]; d[1] = x[1]; d[2] = x[2]; d[3] = x[3];
        }
    __syncthreads();
    const int pp = tid >> 3, kc = tid & 7;
#pragma unroll
    for (int sbt = 0; sbt < 4; ++sbt) {
        f32x4 a, b;
#pragma unroll
        for (int j = 0; j < 4; ++j) { a[j] = tile[sbt * (64 * 65) + (kc * 8 + j) * 65 + pp]; b[j] = tile[sbt * (64 * 65) + (kc * 8 + 4 + j) * 65 + pp]; }
        *(u32x4*)(dst + (size_t)(p0 + sbt * 64 + pp) * K + k0 + kc * 8) = pack8(a, b);
    }
    __syncthreads();
}

__constant__ double ROPE_INV[16] = {1.0, 0.44036660267178046, 0.19392274474868576, 0.08539710028576561, 0.03760603093086393, 0.016560440080994446, 0.007292664737217109, 0.003211445994752591,
                                    0.001414213562373095, 0.000622772421914596, 0.0002742481756762073, 0.00012076973741146504, 5.318295896944988e-05, 2.341999896140934e-05, 1.031338537721246e-05, 4.5416704806078695e-06};

constexpr int KSTR = 272, VOFF_LDS = 256 * KSTR;
__device__ __forceinline__ void attn_prompt_unit(LAS unsigned char* lds, int unit, const bf16_t* Qb, const bf16_t* Kb, const bf16_t* Vb, bf16_t* OG, float* LSE) {
    const int tid = threadIdx.x, w = __builtin_amdgcn_readfirstlane(tid >> 6), lane = tid & 63, fr = lane & 15, fq = lane >> 4;
    const int g = unit >> 8, rem = unit & 255, b = rem >> 6, hs = (rem >> 4) & 3, rb = rem & 15;
    const int sh = 2 * g, lnb = 4 - 2 * g, r = rb >> lnb, blk = rb & ((1 << lnb) - 1);
    const int head = 4 * g + hs;
    const size_t rowbase = (size_t)b * 2048 + r;
    __syncthreads();
#pragma unroll
    for (int it = 0; it < 8; ++it) {
        const int idx = tid + it * 512;
        const int key = idx >> 4, ch = idx & 15;
        int sp = (blk - 1) * 128 + key; if (sp < 0) sp += 128;
        const size_t off = (rowbase + ((size_t)sp << sh)) * AW + head * 128 + ch * 8;
        const u32x4 kv = *(const u32x4*)(Kb + off), vv = *(const u32x4*)(Vb + off);
        *(LAS u32x4*)(lds + key * KSTR + ch * 16) = kv;
        *(LAS u32x4*)(lds + VOFF_LDS + key * KSTR + ch * 16) = vv;
    }
    const int qi = 16 * w + fr;
    const size_t rowq = rowbase + ((size_t)(blk * 128 + qi) << sh);
    bf16x8 qf[4];
#pragma unroll
    for (int ks = 0; ks < 4; ++ks) qf[ks] = *(const bf16x8*)(Qb + rowq * AW + head * 128 + ks * 32 + fq * 8);
    __syncthreads();
    f32x4 sacc[10];
#pragma unroll
    for (int kt = 0; kt < 10; ++kt) {
        sacc[kt] = (f32x4){0.f, 0.f, 0.f, 0.f};
        const int tile = (w + kt) < 15 ? (w + kt) : 15;
#pragma unroll
        for (int ks = 0; ks < 4; ++ks) {
            const bf16x8 kf = *(const LAS bf16x8*)(lds + (tile * 16 + fr) * KSTR + (ks * 32 + fq * 8) * 2);
            sacc[kt] = __builtin_amdgcn_mfma_f32_16x16x32_bf16(kf, qf[ks], sacc[kt], 0, 0, 0);
        }
    }
    float mx = -INFINITY;
#pragma unroll
    for (int kt = 0; kt < 10; ++kt)
#pragma unroll
        for (int j = 0; j < 4; ++j) {
            const int ki = 16 * (w + kt) + 4 * fq + j, dist = 128 + qi - ki;
            const bool valid = (dist >= 0) && (dist <= 128) && (blk > 0 || ki >= 128);
            const float s = valid ? sacc[kt][j] * ATT_SCALE_LOG2E : -INFINITY;
            sacc[kt][j] = s; mx = fmaxf(mx, s);
        }
    mx = fmaxf(mx, __shfl_xor(mx, 16)); mx = fmaxf(mx, __shfl_xor(mx, 32));
    float den = 0.f;
#pragma unroll
    for (int kt = 0; kt < 10; ++kt)
#pragma unroll
        for (int j = 0; j < 4; ++j) { const float p = __builtin_amdgcn_exp2f(sacc[kt][j] - mx); sacc[kt][j] = p; den += p; }
    den += __shfl_xor(den, 16); den += __shfl_xor(den, 32);
    f32x4 oacc[8];
#pragma unroll
    for (int c = 0; c < 8; ++c) oacc[c] = (f32x4){0.f, 0.f, 0.f, 0.f};
    const int q4 = fr >> 2, p4 = fr & 3;
#pragma unroll
    for (int s = 0; s < 5; ++s) {
        bf16x8 pf; u32x4 pw; pw.x = cvt_pk_bf16(sacc[2 * s][0], sacc[2 * s][1]); pw.y = cvt_pk_bf16(sacc[2 * s][2], sacc[2 * s][3]);
        pw.z = cvt_pk_bf16(sacc[2 * s + 1][0], sacc[2 * s + 1][1]); pw.w = cvt_pk_bf16(sacc[2 * s + 1][2], sacc[2 * s + 1][3]);
        pf = __builtin_bit_cast(bf16x8, pw);
        const int t0 = (w + 2 * s) < 15 ? (w + 2 * s) : 15, t1 = (w + 2 * s + 1) < 15 ? (w + 2 * s + 1) : 15;
        const unsigned a0 = VOFF_LDS + (t0 * 16 + 4 * fq + q4) * KSTR + p4 * 8, a1 = VOFF_LDS + (t1 * 16 + 4 * fq + q4) * KSTR + p4 * 8;
#pragma unroll
        for (int c = 0; c < 8; ++c) {
            const s16x4 v0 = __builtin_amdgcn_ds_read_tr16_b64_v4i16((LAS s16x4*)(lds + a0 + c * 32));
            const s16x4 v1 = __builtin_amdgcn_ds_read_tr16_b64_v4i16((LAS s16x4*)(lds + a1 + c * 32));
            bf16x8 vf; vf[0] = v0[0]; vf[1] = v0[1]; vf[2] = v0[2]; vf[3] = v0[3]; vf[4] = v1[0]; vf[5] = v1[1]; vf[6] = v1[2]; vf[7] = v1[3];
            oacc[c] = __builtin_amdgcn_mfma_f32_16x16x32_bf16(vf, pf, oacc[c], 0, 0, 0);
        }
    }
    const float inv = 1.0f / den;
    bf16_t* dst = OG + ((size_t)g * MP + rowq) * AO + hs * 128 + 4 * fq;
#pragma unroll
    for (int c = 0; c < 8; ++c) { u32x2 wv; wv.x = cvt_pk_bf16(oacc[c][0] * inv, oacc[c][1] * inv); wv.y = cvt_pk_bf16(oacc[c][2] * inv, oacc[c][3] * inv); *(u32x2*)(dst + c * 16) = wv; }
    if (fq == 0) LSE[((size_t)g * MP + rowq) * 4 + hs] = (mx + __builtin_amdgcn_logf(den)) * LN2F;
}

__device__ __forceinline__ void attn_sample_unit(int unit, const Args& a, const bf16_t* Qb, bf16_t* OG, float* LSE) {
    const int tid = threadIdx.x, w = tid >> 6, lane = tid & 63, sub = lane & 15, kq = lane >> 4;
    const int idx = unit * 8 + w, b = idx / 48, rem = idx % 48, t = rem / 12, head = rem % 12, g = head >> 2, hs = head & 3, dil = 1 << (2 * g), Wb = 128 * dil;
    const float* ck = g == 0 ? a.in[3] : (g == 1 ? a.in[5] : a.in[7]); const float* cv = g == 0 ? a.in[4] : (g == 1 ? a.in[6] : a.in[8]);
    const float* ok = a.out + kv_group_base(g) + (size_t)4 * Wb * 512; const float* ov = a.out + kv_group_base(g) + (size_t)40 * Wb * 512;
    const size_t row = (size_t)NPR + b * 4 + t, bbase = (size_t)b * Wb * 512 + hs * 128 + 8 * sub;
    f32x4 q0, q1; unpack8(*(const u32x4*)(Qb + row * AW + head * 128 + 8 * sub), q0, q1);
    float m = -INFINITY, l = 0.f; f32x4 o0 = (f32x4){0.f, 0.f, 0.f, 0.f}, o1 = o0;
#pragma unroll 3
    for (int i = 0; i < 33; ++i) {
        const int j = 4 * i + kq; const bool valid = j <= 128;
        const int ci = Wb + t - (valid ? j : 128) * dil;
        const bool fresh = ci >= Wb;
        const float* kp = (fresh ? ok + (size_t)(ci - 4) * 512 : ck + (size_t)ci * 512) + bbase;
        const float* vp = (fresh ? ov + (size_t)(ci - 4) * 512 : cv + (size_t)ci * 512) + bbase;
        const f32x4 k0 = *(const f32x4*)kp, k1 = *(const f32x4*)(kp + 4), v0 = *(const f32x4*)vp, v1 = *(const f32x4*)(vp + 4);
        float s = q0[0] * k0[0] + q0[1] * k0[1] + q0[2] * k0[2] + q0[3] * k0[3] + q1[0] * k1[0] + q1[1] * k1[1] + q1[2] * k1[2] + q1[3] * k1[3];
        s += __shfl_xor(s, 1); s += __shfl_xor(s, 2); s += __shfl_xor(s, 4); s += __shfl_xor(s, 8);
        s = valid ? s * ATT_SCALE_LOG2E : -INFINITY;
        const float mn = fmaxf(m, s), sc = __builtin_amdgcn_exp2f(m - mn), p = __builtin_amdgcn_exp2f(s - mn);
        l = l * sc + p; o0 = o0 * sc + v0 * p; o1 = o1 * sc + v1 * p; m = mn;
    }
#pragma unroll
    for (int x = 16; x <= 32; x <<= 1) {
        const float m2 = __shfl_xor(m, x), l2 = __shfl_xor(l, x);
        f32x4 p0, p1;
#pragma unroll
        for (int e = 0; e < 4; ++e) { p0[e] = __shfl_xor(o0[e], x); p1[e] = __shfl_xor(o1[e], x); }
        const float mn = fmaxf(m, m2), s1 = __builtin_amdgcn_exp2f(m - mn), s2 = __builtin_amdgcn_exp2f(m2 - mn);
        l = l * s1 + l2 * s2; o0 = o0 * s1 + p0 * s2; o1 = o1 * s1 + p1 * s2; m = mn;
    }
    if (kq == 0) {
        const float inv = 1.0f / l;
        *(u32x4*)(OG + ((size_t)g * MP + row) * AO + hs * 128 + 8 * sub) = pack8(o0 * inv, o1 * inv);
        if (sub == 0) LSE[((size_t)g * MP + row) * 4 + hs] = (m + __builtin_amdgcn_logf(l)) * LN2F;
    }
}

__device__ __forceinline__ void conv_unit(LAS unsigned char* lds, int unit, const Args& a, const bf16_t* U, bf16_t* CACT, const f32x2 (&wd)[31], const f32x2 bdw, const f32x2 lng, const f32x2 lnb) {
    const int tid = threadIdx.x, wid = tid >> 6, lane = tid & 63;
    const bool prompt = unit < 512;
    const int b = prompt ? unit >> 7 : unit - 512, t0 = prompt ? (unit & 127) * 16 : 0, ntok = prompt ? 16 : 4, nrows = ntok + 30;
    const size_t row0 = prompt ? (size_t)b * 2048 + t0 : (size_t)NPR + b * 4;
    __syncthreads();
    if (prompt) {
#pragma unroll
        for (int it = 0; it < 12; ++it) {
            const int idx = tid + it * 512, rr = idx >> 7, ch = idx & 127, tt = t0 - 30 + rr;
            if (it < 11 || idx < 46 * 128) {
                u32x4 v = *(const u32x4*)(U + ((size_t)b * 2048 + (tt < 0 ? 0 : tt)) * DC + ch * 8);
                if (tt < 0) v = (u32x4){0u, 0u, 0u, 0u};
                *(LAS u32x4*)(lds + rr * 2048 + ch * 16) = v;
            }
        }
    } else {
        for (int idx = tid; idx < nrows * 128; idx += 512) {
            const int rr = idx >> 7, ch = idx & 127;
            u32x4 v;
            if (rr < 30) { const float* sp_ = a.in[2] + ((size_t)b * 30 + rr) * 1024 + ch * 8; v = pack8(*(const f32x4*)sp_, *(const f32x4*)(sp_ + 4)); }
            else v = *(const u32x4*)(U + (row0 + rr - 30) * DC + ch * 8);
            *(LAS u32x4*)(lds + rr * 2048 + ch * 16) = v;
        }
    }
    __syncthreads();
    f32x2 y[16];
#pragma unroll
    for (int i = 0; i < 16; ++i) y[i] = bdw;
#pragma unroll
    for (int rr = 0; rr < 46; ++rr) {
        const unsigned xw = *(const LAS unsigned*)(lds + rr * 2048 + tid * 4);
        const f32x2 x = (f32x2){bf_lo(xw), bf_hi(xw)};
#pragma unroll
        for (int i = 0; i < 16; ++i) { const int j = rr - i; if (j >= 0 && j <= 30) y[i] += wd[j] * x; }
    }
    LAS float* red = (LAS float*)(lds + 96 * 1024);
#pragma unroll
    for (int i = 0; i < 16; ++i) {
        float s1 = y[i][0] + y[i][1], s2 = y[i][0] * y[i][0] + y[i][1] * y[i][1];
#pragma unroll
        for (int o = 1; o < 64; o <<= 1) { s1 += __shfl_xor(s1, o); s2 += __shfl_xor(s2, o); }
        if (lane == 0) { red[wid * 32 + 2 * i] = s1; red[wid * 32 + 2 * i + 1] = s2; }
    }
    __syncthreads();
    if (tid < 32) { float s = 0.f;
#pragma unroll
        for (int ww = 0; ww < 8; ++ww) s += red[ww * 32 + tid];
        red[256 + tid] = s; }
    __syncthreads();
#pragma unroll
    for (int i = 0; i < 16; ++i) {
        if (i < ntok) {
            const float mu = red[256 + 2 * i] * (1.0f / DC), var = red[256 + 2 * i + 1] * (1.0f / DC) - mu * mu, rs = __builtin_amdgcn_rsqf(var + LN_EPS);
            const float z0 = (y[i][0] - mu) * rs * lng[0] + lnb[0], z1 = (y[i][1] - mu) * rs * lng[1] + lnb[1];
            *(unsigned*)(CACT + (row0 + i) * DC + tid * 2) = cvt_pk_bf16(z0 * sigmoidf_(z0), z1 * sigmoidf_(z1));
        }
    }
}

#define XB_TMO      128
#define XB_XCNT(j)  (256  + 64 * (j))
#define XB_XSUB(j)  (1280 + 64 * (j))
#define XB_XGEN(j)  (2304 + 64 * (j))
#define XB_TOP      3328
#define XB_TOPGEN   3392
#define XCD_BAR_WORDS 3456
#define XB_SPIN_CAP (1u << 18)
__device__ __forceinline__ unsigned xb_ld(unsigned* p)              { return __hip_atomic_load(p, __ATOMIC_RELAXED, __HIP_MEMORY_SCOPE_AGENT); }
__device__ __forceinline__ unsigned xb_add(unsigned* p, unsigned v) { return __hip_atomic_fetch_add(p, v, __ATOMIC_RELAXED, __HIP_MEMORY_SCOPE_AGENT); }
__device__ __forceinline__ unsigned xb_xcc_id() { return (unsigned)__builtin_amdgcn_s_getreg((3 << 11) | 20) & 0xFu; }
#define XB_SPIN(cond, bar) do { unsigned _sp = 0; while (cond) { __builtin_amdgcn_s_sleep(1); \
    if ((++_sp & 255u) == 0u) { if (xb_ld(&(bar)[XB_TMO])) break; if (_sp > XB_SPIN_CAP) { atomicAdd(&(bar)[XB_TMO], 1u); break; } } } } while (0)
struct XcdBarrier { unsigned* bar; unsigned x; volatile LAS unsigned* st; };
__device__ __forceinline__ XcdBarrier xcd_barrier_post(unsigned* bar, volatile LAS unsigned* st) {
    XcdBarrier b; b.bar = bar; b.x = xb_xcc_id(); b.st = st;
    if (threadIdx.x == 0) (void)xb_add(&bar[XB_XCNT(b.x)], 1u);
    return b;
}
__device__ __forceinline__ void xcd_barrier_complete(unsigned* bar, unsigned x, unsigned& nloc, unsigned& nx) {
    const unsigned G = gridDim.x * gridDim.y * gridDim.z;
    unsigned sum, cnt, mine, sp = 0u;
    for (;;) {
        sum = 0u; cnt = 0u; mine = 0u;
#pragma unroll
        for (unsigned j = 0; j < 16; ++j) { const unsigned c = xb_ld(&bar[XB_XCNT(j)]); sum += c; cnt += (c > 0u) ? 1u : 0u; mine = (j == x) ? c : mine; }
        if (sum == G) break;
        __builtin_amdgcn_s_sleep(1);
        if ((++sp & 255u) == 0u) { if (xb_ld(&bar[XB_TMO])) break; if (sp > XB_SPIN_CAP) { atomicAdd(&bar[XB_TMO], 1u); break; } }
    }
    nloc = mine > 0u ? mine : 1u; nx = cnt > 0u ? cnt : 1u;
}
__device__ __forceinline__ void xcd_barrier(const XcdBarrier& b) {
    asm volatile("s_waitcnt vmcnt(0)" ::: "memory");
    __syncthreads();
    if (threadIdx.x == 0) {
        unsigned* bar = b.bar;
        __builtin_amdgcn_s_waitcnt(0);
        unsigned nloc = b.st[0], nx = b.st[1];
        if (nloc == 0u) { xcd_barrier_complete(bar, b.x, nloc, nx); b.st[0] = nloc; b.st[1] = nx; }
        const unsigned old = xb_add(&bar[XB_XSUB(b.x)], 1u);
        const unsigned gen = old / nloc;
        if (old + 1u == (gen + 1u) * nloc) {
            __builtin_amdgcn_fence(__ATOMIC_RELEASE, "agent");
            asm volatile("s_waitcnt vmcnt(0)" ::: "memory");
            const unsigned og = xb_add(&bar[XB_TOP], 1u);
            const unsigned tg = og / nx;
            if (og + 1u == (tg + 1u) * nx) xb_add(&bar[XB_TOPGEN], 1u);
            else XB_SPIN(xb_ld(&bar[XB_TOPGEN]) == tg, bar);
            __builtin_amdgcn_fence(__ATOMIC_ACQUIRE, "agent");
            xb_add(&bar[XB_XGEN(b.x)], 1u);
            asm volatile("s_waitcnt vmcnt(0)" ::: "memory");
        } else {
            XB_SPIN(xb_ld(&bar[XB_XGEN(b.x)]) == gen, bar);
            __builtin_amdgcn_fence(__ATOMIC_ACQUIRE, "agent");
            asm volatile("s_waitcnt vmcnt(0)" ::: "memory");
        }
    }
    __syncthreads();
}

__global__ void __launch_bounds__(512, 2) mega(Args a) {
    extern __shared__ __attribute__((aligned(16))) unsigned char shm[];
    LAS unsigned char* lds = (LAS unsigned char*)shm;
    cg::grid_group grid = cg::this_grid();
    const int tid = threadIdx.x, wid = tid >> 6, lane = tid & 63, G = gridDim.x, bid = blockIdx.x;
    unsigned char* ws = a.ws; unsigned* ctl = (unsigned*)(ws + WS_CTL);
    bf16_t* XA = (bf16_t*)(ws + WS_XA); bf16_t* T1 = (bf16_t*)(ws + WS_T1); bf16_t* MIX = (bf16_t*)(ws + WS_MIX); float* X1 = (float*)(ws + WS_X1);
    bf16_t* U = (bf16_t*)(ws + WS_U); bf16_t* Qb = (bf16_t*)(ws + WS_Q); bf16_t* Kb = (bf16_t*)(ws + WS_K); bf16_t* Vb = (bf16_t*)(ws + WS_V);
    bf16_t* GC = (bf16_t*)(ws + WS_GC); bf16_t* GA = (bf16_t*)(ws + WS_GA); bf16_t* CACT = (bf16_t*)(ws + WS_CACT); bf16_t* OG = (bf16_t*)(ws + WS_OG); bf16_t* OATT = (bf16_t*)(ws + WS_OATT);
    bf16_t* HID = (bf16_t*)(ws + WS_HID); float* SS1 = (float*)(ws + WS_SS1); float* SS2 = (float*)(ws + WS_SS2); float* ROPE = (float*)(ws + WS_ROPE); float* LSE = (float*)(ws + WS_LSE);
#define PH(p) if (a.ph_lo <= (p) && (p) < a.ph_hi)
#define SEAM(p) if (a.ph_lo <= (p) && (p) + 1 < a.ph_hi) xcd_barrier(xb)

    volatile LAS unsigned* xst = (volatile LAS unsigned*)(lds + LDS_BYTES - 16);
    if (tid == 0) { xst[0] = 0u; xst[1] = 0u; LAS unsigned long long* pt = (LAS unsigned long long*)(lds + LDS_BYTES - 128);
        pt[0] = (unsigned long long)a.in[3]; pt[1] = (unsigned long long)a.in[4]; pt[2] = (unsigned long long)a.in[5]; pt[3] = (unsigned long long)a.in[6]; pt[4] = (unsigned long long)a.in[7]; pt[5] = (unsigned long long)a.in[8]; }
    CacheStream cs; cs.ci = 0; cs.c = bid; cs.step = G; cs.out = a.out; cs.sbase = nullptr; cs.dbase = nullptr; cs.ncache = 0; cs.cur_src = nullptr; cs.cur_dst = nullptr; cs.inflight = false; NoStream ns;
    __syncthreads();
    cs.setup(lds);
    XcdBarrier xb = xcd_barrier_post((unsigned*)(ws + WS_CTL), xst);
    if (a.ph_hi > 1000) grid.sync();
    PH(0) {
        const int gt = bid * 512 + tid, GT = G * 512;
        for (int i = gt; i < 2 * 16384; i += GT) __hip_atomic_store((float*)(ws + WS_SS1) + i, 0.f, __ATOMIC_RELAXED, __HIP_MEMORY_SCOPE_AGENT);
        for (int i = gt; i < 2052 * 16; i += GT) {
            const int pi = i >> 4, fi = i & 15; const double pos = pi < 2048 ? (double)pi : (double)(8192 + pi - 2048);
            const double rev = pos * ROPE_INV[fi] * 0.15915494309189535; const float fr_ = (float)(rev - floor(rev));
            ROPE[2 * i] = __builtin_amdgcn_cosf(fr_); ROPE[2 * i + 1] = __builtin_amdgcn_sinf(fr_);
        }
        for (int row = bid * 8 + wid; row < MR; row += G * 8) {
            const float* src = row < NPR ? a.in[0] + (size_t)row * DM : a.in[1] + (size_t)(row - NPR) * DM;
            f32x4 v[8]; float ss = 0.f;
#pragma unroll
            for (int i = 0; i < 4; ++i) { v[2 * i] = *(const f32x4*)(src + (i * 64 + lane) * 8); v[2 * i + 1] = *(const f32x4*)(src + (i * 64 + lane) * 8 + 4); }
#pragma unroll
            for (int i = 0; i < 8; ++i) ss += v[i][0] * v[i][0] + v[i][1] * v[i][1] + v[i][2] * v[i][2] + v[i][3] * v[i][3];
#pragma unroll
            for (int o = 1; o < 64; o <<= 1) ss += __shfl_xor(ss, o);
            const float r = __builtin_amdgcn_rsqf(ss * (1.0f / DM) + NORM_EPS);
#pragma unroll
            for (int i = 0; i < 4; ++i) { const int c = (i * 64 + lane) * 8; const f32x4 g0 = *(const f32x4*)(a.in[9] + c), g1 = *(const f32x4*)(a.in[9] + c + 4);
                *(u32x4*)(XA + (size_t)row * DM + c) = pack8(v[2 * i] * r * g0, v[2 * i + 1] * r * g1); }
        }
        {
#define WCOPY(KIND, w0, w1, ldw, K, Np, ksc, dst) do { const int npt_ = (Np) / 256, nu_ = ((K) / 64) * npt_; \
                for (int uidx = bid; uidx < nu_; uidx += G) wcopy_unit<KIND>((LAS float*)lds, w0, w1, ldw, K, ksc, dst, uidx / npt_, uidx % npt_); } while (0)
            WCOPY(1, a.in[10], nullptr, INC, DM, INC, nullptr, (bf16_t*)(ws + WS_WIN));
            WCOPY(0, a.in[16], nullptr, DM, DC, DM, nullptr, (bf16_t*)(ws + WS_WPW));
            WCOPY(0, a.in[18], nullptr, DM, AO, DM, nullptr, (bf16_t*)(ws + WS_WOA));
            WCOPY(0, a.in[19], nullptr, DM, DM, DM, nullptr, (bf16_t*)(ws + WS_WOUT));
            WCOPY(2, a.in[21], a.in[22], FH, DM, 2 * FH, a.in[20], (bf16_t*)(ws + WS_WGU));
            WCOPY(0, a.in[23], nullptr, DM, FH, DM, nullptr, (bf16_t*)(ws + WS_WDN));
#undef WCOPY
        }
        for (int i = gt; i < 32 * 26 * 256; i += GT) { const int bb = i / (26 * 256), rr = i - bb * 26 * 256; ((f32x4*)(a.out + OFF_CONVS))[(size_t)bb * 30 * 256 + rr] = ((const f32x4*)a.in[2])[(size_t)bb * 30 * 256 + 4 * 256 + rr]; }
    }
    SEAM(0);
    PH(1) {
        pg8::Gemm gm{XA, (const bf16_t*)(ws + WS_WIN), NPR, INC, DM};
        pg8::StaticOrder S; S.init(NPR, INC, G, bid);
        TileEpi<EpiIn> E{EpiIn{U, Qb, Kb, Vb, GC, GA, a.out, a.in[11], ROPE}};
        pg8::gemm_phase(lds, gm, S, E, cs);
        skinny_phase(lds, XA, (const bf16_t*)(ws + WS_WIN), DM, INC, E.e, 64);
    }
    SEAM(1);
    PH(2) {
        {
            const int nmine = (768 + 192 - bid + G - 1) / G;
            for (int i = 0; i < nmine; ++i) {
                const int k = (i + bid) % nmine, u = bid + k * G;
                if (u < 768) attn_prompt_unit(lds, u, Qb, Kb, Vb, OG, LSE);
                else attn_sample_unit(u - 768, a, Qb, OG, LSE);
            }
        }
        if (bid < 544) {
            f32x2 wd[31];
#pragma unroll
            for (int j = 0; j < 31; ++j) wd[j] = *(const f32x2*)(a.in[12] + j * 1024 + tid * 2);
            const f32x2 bdw = *(const f32x2*)(a.in[13] + tid * 2), lng = *(const f32x2*)(a.in[14] + tid * 2), lnb = *(const f32x2*)(a.in[15] + tid * 2);
            for (int u = G - 1 - bid; u < 544; u += G) conv_unit(lds, u, a, U, CACT, wd, bdw, lng, lnb);
        }
    }
    SEAM(2);
    PH(3) {
        for (int u = bid; u < MR / 32; u += G) {
#pragma unroll
            for (int i = 0; i < 4; ++i) {
                const int idx = tid + 512 * i, row = u * 32 + (idx >> 6), ch = idx & 63, hs = ch >> 4;
                const float l0 = LSE[((size_t)0 * MP + row) * 4 + hs], l1 = LSE[((size_t)1 * MP + row) * 4 + hs], l2 = LSE[((size_t)2 * MP + row) * 4 + hs];
                const float mx = fmaxf(l0, fmaxf(l1, l2)), e0 = __expf(l0 - mx), e1 = __expf(l1 - mx), e2 = __expf(l2 - mx), inv = 1.0f / (e0 + e1 + e2);
                f32x4 a0, b0, a1, b1, a2, b2;
                unpack8(*(const u32x4*)(OG + ((size_t)0 * MP + row) * AO + ch * 8), a0, b0);
                unpack8(*(const u32x4*)(OG + ((size_t)1 * MP + row) * AO + ch * 8), a1, b1);
                unpack8(*(const u32x4*)(OG + ((size_t)2 * MP + row) * AO + ch * 8), a2, b2);
                *(u32x4*)(OATT + (size_t)row * AO + ch * 8) = pack8((a0 * e0 + a1 * e1 + a2 * e2) * inv, (b0 * e0 + b1 * e1 + b2 * e2) * inv);
            }
        }
    }
    SEAM(3);
    PH(4) {
        pg8::StaticOrder S; S.init(NPR, DM, G, bid);
        TileEpi<EpiPw> E1{EpiPw{T1, GC, a.in[17]}}; TileEpi<EpiOa> E2{EpiOa{T1, GA, MIX}};
        { pg8::Gemm gm{CACT, (const bf16_t*)(ws + WS_WPW), NPR, DM, DC}; pg8::gemm_phase(lds, gm, S, E1, ns); }
        { pg8::Gemm gm{OATT, (const bf16_t*)(ws + WS_WOA), NPR, DM, AO}; pg8::gemm_phase(lds, gm, S, E2, ns); }
        skinny_phase(lds, CACT, (const bf16_t*)(ws + WS_WPW), DC, DM, E1.e, 0);
        skinny_phase(lds, OATT, (const bf16_t*)(ws + WS_WOA), AO, DM, E2.e, 0);
    }
    SEAM(4);
    PH(5) {
        pg8::Gemm gm{MIX, (const bf16_t*)(ws + WS_WOUT), NPR, DM, DM};
        pg8::StaticOrder S; S.init(NPR, DM, G, bid);
        TileEpi<EpiRes> E{EpiRes{a.in[0], a.in[1], (size_t)NPR, nullptr, XA, SS1, nullptr}};
        pg8::gemm_phase(lds, gm, S, E, ns);
        skinny_phase(lds, MIX, (const bf16_t*)(ws + WS_WOUT), DM, DM, E.e, 0);
    }
    SEAM(5);
    PH(6) {
        pg8::Gemm gm{XA, (const bf16_t*)(ws + WS_WGU), NPR, 2 * FH, DM};
        pg8::StaticOrder S; S.init(NPR, 2 * FH, G, bid);
        TileEpi<EpiGu> E{EpiGu{SS1, HID}};
        pg8::gemm_phase(lds, gm, S, E, cs);
        skinny_phase(lds, XA, (const bf16_t*)(ws + WS_WGU), DM, 2 * FH, E.e, 128);
    }
    SEAM(6);
    PH(7) {
        pg8::Gemm gm{HID, (const bf16_t*)(ws + WS_WDN), NPR, DM, FH};
        pg8::StaticOrder S; S.init(NPR, DM, G, bid);
        TileEpi<EpiRes> E{EpiRes{nullptr, nullptr, (size_t)0, a.out, nullptr, SS2, XA}};
        if (G == 256) {
            EpiFinalTile EF{XA, a.out, SS2, ctl, a.in[24]}; pg8::gemm_phase(lds, gm, S, EF, ns);
            EpiFinalRow ER{XA, a.out, SS2, ctl, a.in[24]}; skinny_phase(lds, HID, (const bf16_t*)(ws + WS_WDN), FH, DM, ER, 0);
        } else {
            pg8::gemm_phase(lds, gm, S, E, ns);
            skinny_phase(lds, HID, (const bf16_t*)(ws + WS_WDN), FH, DM, E.e, 0);
        }
        while (cs.ci < 6) {
            f32x4 v[8]; float* d[8];
#pragma unroll
            for (int k = 0; k < 8; ++k) { d[k] = nullptr; if (cs.ci < 6) { cs.decode_next(lds); d[k] = cs.cur_dst; v[k] = __builtin_nontemporal_load((const f32x4*)(cs.cur_src + tid * 4)); } }
#pragma unroll
            for (int k = 0; k < 8; ++k) if (d[k]) __builtin_nontemporal_store(v[k], (f32x4*)(d[k] + tid * 4));
        }
    }
    if (G != 256) {
    SEAM(7);
    PH(8) {
        for (int row = bid * 8 + wid; row < MR; row += G * 8) {
            float* p = a.out + (size_t)row * DM;
            const float r = __builtin_amdgcn_rsqf(SS2[row] * (1.0f / DM) + NORM_EPS);
#pragma unroll
            for (int i = 0; i < 8; ++i) { const int c = (i * 64 + lane) * 4; *(f32x4*)(p + c) = *(const f32x4*)(p + c) * r * *(const f32x4*)(a.in[24] + c); }
        }
    }
    }
}

extern "C" void kernel_launch(void* const* d_in, const int* in_sizes, int n_in, void* d_out, int out_size, void* d_ws, size_t ws_size, hipStream_t stream) {
    static int grid = 0;
    if (grid == 0) {
        if (n_in != 25 || ws_size < WS_END) { fprintf(stderr, "kernel_launch: need 25 inputs and %zu bytes of workspace; got %d, %zu\n", (size_t)WS_END, n_in, ws_size); grid = -1; return; }
        int dev = 0, cus = 0, per_cu = 0;
        (void)hipGetDevice(&dev); (void)hipDeviceGetAttribute(&cus, hipDeviceAttributeMultiprocessorCount, dev);
        if (hipFuncSetAttribute((const void*)mega, hipFuncAttributeMaxDynamicSharedMemorySize, LDS_BYTES) != hipSuccess) { fprintf(stderr, "kernel_launch: hipFuncSetAttribute failed\n"); grid = -1; return; }
        if (hipOccupancyMaxActiveBlocksPerMultiprocessor(&per_cu, (const void*)mega, 512, LDS_BYTES) != hipSuccess || per_cu < 1) { fprintf(stderr, "kernel_launch: occupancy query says %d\n", per_cu); per_cu = 1; }
        (void)hipGetLastError();
        grid = cus * 1;
        if (grid > 512) grid = 512;
    }
    if (grid < 0) return;
    (void)hipMemsetAsync((char*)d_ws + WS_CTL, 0, 40960, stream);
    Args a{};
    for (int i = 0; i < 25; ++i) a.in[i] = (const float*)d_in[i];
    a.out = (float*)d_out; a.ws = (unsigned char*)d_ws;
#if MK_SPLIT
    for (int p = 0; p < 9; ++p) { a.ph_lo = p; a.ph_hi = p + 1; hipLaunchKernelGGL(mega, dim3(grid), dim3(512), LDS_BYTES, stream, a); }
#else
    a.ph_lo = 0; a.ph_hi = 9;
    void* args[] = {&a};
    hipError_t e = hipLaunchCooperativeKernel((const void*)mega, dim3(grid), dim3(512), args, LDS_BYTES, stream);
    if (e != hipSuccess) fprintf(stderr, "kernel_launch: cooperative launch failed: %s (grid %d)\n", hipGetErrorString(e), grid);
#endif
}
```
